# Optimizing an MI355X kernel written in HIP

```python
import jax, jax.numpy as jnp
from jax import lax
import numpy as np

D_MODEL = 1024
BATCH = 8
SEQ = 4096
DEPTH = 1
DEC_BATCH = 32
DEC_SEQ = 8
PAST_LEN = 16384
PAGE_SIZE = 128

PLE_DIM = 256
NORM_EPS = 1e-6
GLA_HEADS = 4
GLA_DK = D_MODEL // 2 // GLA_HEADS
GLA_DV = D_MODEL // GLA_HEADS
GLA_KEY = GLA_HEADS * GLA_DK
GLA_VAL = GLA_HEADS * GLA_DV
GLA_LOWRANK = 16
GLA_TAU = 16.0
GLA_CHUNK = 64
DIL_GROUPS = ((128, 1), (512, 4), (2048, 16))
DIL_HEADS = 4
DIL_HD = 128
DIL_WIDTH = DIL_HEADS * DIL_HD
DIL_QKV = len(DIL_GROUPS) * DIL_WIDTH
IN_SPLITS = (GLA_KEY, GLA_KEY, GLA_VAL, GLA_VAL, GLA_LOWRANK,
             DIL_QKV, DIL_QKV, DIL_QKV, DIL_WIDTH, D_MODEL, D_MODEL)
IN_WIDTH = sum(IN_SPLITS)

kernel_name = "gla_dilated_window_gated_hybrid_step"


def _rmsnorm(x, g):
    xf = x.astype(jnp.float32)
    y = xf * lax.rsqrt(jnp.mean(xf * xf, axis=-1, keepdims=True) + NORM_EPS)
    return (y * g.astype(jnp.float32)).astype(x.dtype)


def _gla(q, k, v, log_a, s0):
    f32 = jnp.float32
    B, L, H, DK = q.shape
    DV = v.shape[-1]
    C = min(GLA_CHUNK, L)
    n = -(-L // C)
    pad = n * C - L

    def chunks(t):
        t = jnp.pad(t.astype(f32), ((0, 0), (0, pad), (0, 0), (0, 0)))
        return jnp.moveaxis(t.reshape(B, n, C, H, t.shape[-1]), 1, 0)

    qc, kc, vc, ac = chunks(q), chunks(k), chunks(v), chunks(log_a)
    causal = jnp.tril(jnp.ones((C, C), dtype=bool))

    def step(s, inp):
        q_, k_, v_, a_ = inp
        b = jnp.cumsum(a_, axis=1)
        b_end = b[:, -1]
        q_in = q_ * jnp.exp(b)
        att = jnp.einsum('bihd,bjhd->bhij', q_in, k_ * jnp.exp(-b))
        att = jnp.where(causal, att, 0.0)
        o = (jnp.einsum('bhij,bjhe->bihe', att, v_)
             + jnp.einsum('bihd,bhde->bihe', q_in, s))
        k_end = k_ * jnp.exp(b_end[:, None] - b)
        s = jnp.exp(b_end)[..., None] * s + jnp.einsum('bjhd,bjhe->bhde', k_end, v_)
        return s, o

    s_fin, o = lax.scan(step, s0.astype(f32), (qc, kc, vc, ac))
    o = jnp.moveaxis(o, 0, 1).reshape(B, n * C, H, DV)[:, :L]
    return o, s_fin


def _dilated_prompt(q, k, v, dil, span):
    f32 = jnp.float32
    B, S, H, D = q.shape
    L = S // dil
    nb = -(-L // span)

    def split(t):
        t = t.astype(f32).reshape(B, L, dil, H, D)
        t = jnp.pad(t, ((0, 0), (0, nb * span - L), (0, 0), (0, 0), (0, 0)))
        return t.reshape(B, nb, span, dil, H, D)

    qs, ks, vs = split(q), split(k), split(v)

    def with_prev(t):
        prev = jnp.pad(t, ((0, 0), (1, 0), (0, 0), (0, 0), (0, 0), (0, 0)))[:, :-1]
        return jnp.concatenate([prev, t], axis=2)

    kk, vv = with_prev(ks), with_prev(vs)
    i = span + jnp.arange(span)[:, None]
    j = jnp.arange(2 * span)[None, :]
    band = (i - j >= 0) & (i - j <= span)
    first = (jnp.arange(nb)[:, None, None] == 0) & (j < span)[None]
    valid = (band[None] & ~first)[None, :, None, None]
    s = jnp.einsum('bnirhd,bnjrhd->bnrhij', qs, kk) * (D ** -0.5)
    s = jnp.where(valid, s, -jnp.inf)
    m = jnp.max(s, axis=-1, keepdims=True)
    p = jnp.exp(s - m)
    l = jnp.sum(p, axis=-1, keepdims=True)
    o = jnp.einsum('bnrhij,bnjrhd->bnirhd', p / l, vv)
    lse = jnp.moveaxis((m + jnp.log(l))[..., 0], -1, 2)
    o = o.reshape(B, nb * span, dil, H, D)[:, :L].reshape(B, S, H, D)
    lse = lse.reshape(B, nb * span, dil, H)[:, :L].reshape(B, S, H)
    return o, lse


def _dilated_sample(q, k, v, buf, dil, span):
    f32 = jnp.float32
    B, T, H, D = q.shape
    Lb = buf.shape[1]
    kk = jnp.concatenate([buf[:, :, 0].astype(f32), k.astype(f32)], axis=1)
    vv = jnp.concatenate([buf[:, :, 1].astype(f32), v.astype(f32)], axis=1)
    idx = Lb + jnp.arange(T)[:, None] - dil * jnp.arange(span + 1)[None, :]
    valid = (idx >= 0)[None, :, None, :]
    idx = jnp.maximum(idx, 0)
    kg = jnp.take(kk, idx, axis=1)
    vg = jnp.take(vv, idx, axis=1)
    s = jnp.einsum('bthd,btkhd->bthk', q.astype(f32), kg) * (D ** -0.5)
    s = jnp.where(valid, s, -jnp.inf)
    m = jnp.max(s, axis=-1, keepdims=True)
    p = jnp.exp(s - m)
    l = jnp.sum(p, axis=-1, keepdims=True)
    o = jnp.einsum('bthk,btkhd->bthd', p / l, vg)
    lse = (m + jnp.log(l))[..., 0]
    keep = min(dil * span, Lb + T)
    new_buf = jnp.stack([kk, vv], axis=2)[:, Lb + T - keep:].astype(buf.dtype)
    return o, lse, new_buf


def _layer(x, pe, gla_s0, bufs, g_pre, g_post, w_in, w_gla_lr, b_gla_lr, g_gla_norm,
           w_gla_branch, w_dil_branch, w_out, w_ple_proj, w_ple_gate):
    B, L, _ = x.shape
    xn = _rmsnorm(x, g_pre)
    u = xn @ w_in
    cuts = np.cumsum(IN_SPLITS)[:-1].tolist()
    gq, gk, gv, gg, glr, dq, dk, dv, dg, ga, gb = jnp.split(u, cuts, axis=-1)

    q = gq.reshape(B, L, GLA_HEADS, GLA_DK) * (GLA_DK ** -0.5)
    k = gk.reshape(B, L, GLA_HEADS, GLA_DK)
    v = gv.reshape(B, L, GLA_HEADS, GLA_DV)
    z = (glr @ w_gla_lr + b_gla_lr).astype(jnp.float32)
    log_a = (jax.nn.log_sigmoid(z) / GLA_TAU).reshape(B, L, GLA_HEADS, GLA_DK)
    o_a, s_new = _gla(q, k, v, log_a, gla_s0)
    o_a = _rmsnorm(o_a.astype(x.dtype), g_gla_norm.reshape(GLA_HEADS, GLA_DV)).reshape(B, L, GLA_VAL)
    y_a = (o_a * jax.nn.silu(gg)) @ w_gla_branch

    ng = len(DIL_GROUPS)
    dq = dq.reshape(B, L, ng, DIL_HEADS, DIL_HD)
    dk = dk.reshape(B, L, ng, DIL_HEADS, DIL_HD)
    dv = dv.reshape(B, L, ng, DIL_HEADS, DIL_HD)
    outs, lses, new_bufs = [], [], []
    for g, (win, dil) in enumerate(DIL_GROUPS):
        span = win // dil
        qg, kg, vg = dq[:, :, g], dk[:, :, g], dv[:, :, g]
        if bufs is None:
            o_g, lse_g = _dilated_prompt(qg, kg, vg, dil, span)
            keep = min(win, L)
            nbuf = jnp.stack([kg, vg], axis=2)[:, L - keep:]
        else:
            o_g, lse_g, nbuf = _dilated_sample(qg, kg, vg, bufs[g], dil, span)
        outs.append(o_g)
        lses.append(lse_g)
        new_bufs.append(nbuf)
    wts = jax.nn.softmax(jnp.stack(lses), axis=0)
    o_b = jnp.einsum('gblh,gblhd->blhd', wts, jnp.stack(outs)).reshape(B, L, DIL_WIDTH)
    y_b = (o_b.astype(x.dtype) * jax.nn.silu(dg)) @ w_dil_branch

    merged = jax.nn.sigmoid(ga) * y_a + jax.nn.sigmoid(gb) * y_b
    h = x + _rmsnorm(merged @ w_out, g_post)
    h = h + (pe @ w_ple_proj) * jax.nn.sigmoid(h @ w_ple_gate)
    return h, s_new.astype(x.dtype), new_bufs


def setup_inputs(seed: int = 0) -> dict:
    key = jax.random.key(seed)
    ks = jax.random.split(key, 24)
    f32 = jnp.float32
    nrm = lambda k, shape, sc: jax.random.normal(k, shape, f32) * sc
    buf_len = [min(w, PAST_LEN) for (w, _) in DIL_GROUPS]
    return {
        "x_prompt": nrm(ks[0], (BATCH, SEQ, D_MODEL), 1.0),
        "x_sample": nrm(ks[1], (DEC_BATCH, DEC_SEQ, D_MODEL), 1.0),
        "state_gla": nrm(ks[2], (DEPTH, DEC_BATCH, GLA_HEADS, GLA_DK, GLA_DV), 1.0),
        "cache_kv_w128": nrm(ks[3], (DEPTH, DEC_BATCH, buf_len[0], 2, DIL_HEADS, DIL_HD), 1.0),
        "cache_kv_w512": nrm(ks[4], (DEPTH, DEC_BATCH, buf_len[1], 2, DIL_HEADS, DIL_HD), 1.0),
        "cache_kv_w2048": nrm(ks[5], (DEPTH, DEC_BATCH, buf_len[2], 2, DIL_HEADS, DIL_HD), 1.0),
        "p_prompt": nrm(ks[6], (DEPTH, BATCH, SEQ, PLE_DIM), 1.0),
        "p_sample": nrm(ks[7], (DEPTH, DEC_BATCH, DEC_SEQ, PLE_DIM), 1.0),
        "g_pre": 1.0 + nrm(ks[8], (DEPTH, D_MODEL), 0.02),
        "g_post": 1.0 + nrm(ks[9], (DEPTH, D_MODEL), 0.02),
        "w_in": nrm(ks[10], (DEPTH, D_MODEL, IN_WIDTH), D_MODEL ** -0.5),
        "w_gla_lr": nrm(ks[11], (DEPTH, GLA_LOWRANK, GLA_KEY), GLA_LOWRANK ** -0.5),
        "b_gla_lr": nrm(ks[12], (DEPTH, GLA_KEY), 0.02),
        "g_gla_norm": 1.0 + nrm(ks[13], (DEPTH, GLA_VAL), 0.02),
        "w_gla_branch": nrm(ks[14], (DEPTH, GLA_VAL, D_MODEL), GLA_VAL ** -0.5),
        "w_dil_branch": nrm(ks[15], (DEPTH, DIL_WIDTH, D_MODEL), DIL_WIDTH ** -0.5),
        "w_out": nrm(ks[16], (DEPTH, D_MODEL, D_MODEL), D_MODEL ** -0.5),
        "w_ple_proj": nrm(ks[17], (DEPTH, PLE_DIM, D_MODEL), PLE_DIM ** -0.5),
        "w_ple_gate": nrm(ks[18], (DEPTH, D_MODEL, D_MODEL), D_MODEL ** -0.5),
    }


def reference(x_prompt, x_sample, state_gla, cache_kv_w128, cache_kv_w512, cache_kv_w2048,
              p_prompt, p_sample, g_pre, g_post, w_in, w_gla_lr, b_gla_lr, g_gla_norm,
              w_gla_branch, w_dil_branch, w_out, w_ple_proj, w_ple_gate):
    hp, hs = x_prompt, x_sample
    gla_p, gla_s = [], []
    kvp = [[], [], []]
    kvs = [[], [], []]
    for i in range(DEPTH):
        lw = (g_pre[i], g_post[i], w_in[i], w_gla_lr[i], b_gla_lr[i], g_gla_norm[i],
              w_gla_branch[i], w_dil_branch[i], w_out[i], w_ple_proj[i], w_ple_gate[i])
        s0 = jnp.zeros((x_prompt.shape[0], GLA_HEADS, GLA_DK, GLA_DV), x_prompt.dtype)
        hp, sp_new, bp_new = _layer(hp, p_prompt[i], s0, None, *lw)
        hs, ss_new, bs_new = _layer(hs, p_sample[i], state_gla[i],
                                    (cache_kv_w128[i], cache_kv_w512[i], cache_kv_w2048[i]), *lw)
        gla_p.append(sp_new)
        gla_s.append(ss_new)
        for g in range(len(DIL_GROUPS)):
            kvp[g].append(bp_new[g])
            kvs[g].append(bs_new[g])
    state_gla_prompt = jnp.stack(gla_p)
    state_gla_sample = jnp.stack(gla_s)
    kv_w128_prompt, kv_w512_prompt, kv_w2048_prompt = (jnp.stack(kvp[0]), jnp.stack(kvp[1]), jnp.stack(kvp[2]))
    kv_w128_sample, kv_w512_sample, kv_w2048_sample = (jnp.stack(kvs[0]), jnp.stack(kvs[1]), jnp.stack(kvs[2]))
    return (hp, hs, state_gla_prompt, state_gla_sample,
            kv_w128_prompt, kv_w512_prompt, kv_w2048_prompt,
            kv_w128_sample, kv_w512_sample, kv_w2048_sample)
```

```cpp
#include <hip/hip_runtime.h>
#include <hip/hip_cooperative_groups.h>
#include <cstdio>
#include <cstdint>
namespace cg = cooperative_groups;

#ifndef MK_SINGLE
#define MK_SINGLE 1
#endif

#define LAS __attribute__((address_space(3)))
typedef unsigned short bf16_t;
typedef short bf16x8 __attribute__((ext_vector_type(8)));
typedef short s16x4 __attribute__((ext_vector_type(4)));
typedef float f32x4 __attribute__((ext_vector_type(4)));
typedef float f32x2 __attribute__((ext_vector_type(2)));
typedef unsigned u32x4 __attribute__((ext_vector_type(4)));
typedef unsigned u32x2 __attribute__((ext_vector_type(2)));

constexpr int DM = 1024, NBATCH = 8, SEQ = 4096, MP = NBATCH * SEQ, DECB = 32, DECT = 8, MS = DECB * DECT, M = MP + MS;
constexpr int NU = 10240;
constexpr int UQ = 0, UK = 512, UV = 1024, UG = 2048, UDQ = 3072, UDK = 4608, UDV = 6144, UDG = 7680, UGA = 8192, UGB = 9216;
constexpr int WIN_W = 10256;
constexpr float NORM_EPS = 1e-6f;
constexpr float QSCALE = 0.08838834764831845f;

constexpr size_t al256(size_t x) { return (x + 255) & ~(size_t)255; }
constexpr size_t WS_CTL = 0;
constexpr size_t WS_XN = 1u << 20;
constexpr size_t WS_GLR = WS_XN + al256((size_t)M * 1024 * 2);
constexpr size_t WS_WIN = WS_GLR + al256((size_t)M * 16 * 4);
constexpr size_t WS_WAB = WS_WIN + al256((size_t)NU * 1024 * 2);
constexpr size_t WS_WO = WS_WAB + al256((size_t)1024 * 1536 * 2);
constexpr size_t WS_WG = WS_WO + al256((size_t)1024 * 1024 * 2);
constexpr size_t WS_WP = WS_WG + al256((size_t)1024 * 1024 * 2);
constexpr size_t WS_PE = WS_WP + al256((size_t)1024 * 256 * 2);
constexpr size_t WS_U = WS_PE + al256((size_t)M * 256 * 2);
constexpr size_t WS_OA = WS_U + al256((size_t)M * NU * 2);
constexpr size_t WS_OG = WS_OA + al256((size_t)M * 1024 * 2);
constexpr size_t WS_LSE = WS_OG + al256((size_t)3 * M * 512 * 2);
constexpr size_t WS_AB = WS_LSE + al256((size_t)3 * M * 4 * 4);
constexpr size_t WS_END = WS_AB + al256((size_t)M * 1536 * 2);
static_assert(WS_END <= (size_t)1073741824, "workspace map exceeds 4x largest tensor");

constexpr size_t O_Y = 0;
constexpr size_t O_SGP = (size_t)M * 1024;
constexpr size_t O_SGS = O_SGP + (size_t)8 * 4 * 128 * 256;
constexpr size_t O_KVP0 = O_SGS + (size_t)32 * 4 * 128 * 256;
constexpr size_t O_KVP1 = O_KVP0 + (size_t)8 * 128 * 1024;
constexpr size_t O_KVP2 = O_KVP1 + (size_t)8 * 512 * 1024;
constexpr size_t O_KVS0 = O_KVP2 + (size_t)8 * 2048 * 1024;
constexpr size_t O_KVS1 = O_KVS0 + (size_t)32 * 128 * 1024;
constexpr size_t O_KVS2 = O_KVS1 + (size_t)32 * 512 * 1024;

constexpr int LDS_BYTES = 147456;
constexpr int CW_BAR = 4096;
constexpr size_t CTL_ZERO_BYTES = 65536;
#ifndef PROBE_Q
#define PROBE_Q (-1)
#define PROBE_LO 0
#define PROBE_HI 0
#endif
#ifndef PROBE_DUP
#define PROBE_DUP (-1)
#endif

__device__ __forceinline__ unsigned cvt_pk_bf16_asm(float lo, float hi) { unsigned r; asm volatile("v_cvt_pk_bf16_f32 %0, %1, %2" : "=v"(r) : "v"(lo), "v"(hi)); return r; }
typedef __bf16 bf16x2_t __attribute__((ext_vector_type(2)));
__device__ __forceinline__ unsigned cvt_pk_bf16(float lo, float hi) { const f32x2 v = {lo, hi}; const bf16x2_t r = __builtin_convertvector(v, bf16x2_t); return __builtin_bit_cast(unsigned, r); }
__device__ __forceinline__ float bflo(unsigned u) { return __uint_as_float(u << 16); }
__device__ __forceinline__ float bfhi(unsigned u) { return __uint_as_float(u & 0xffff0000u); }
__device__ __forceinline__ float bf1(bf16_t u) { return __uint_as_float(((unsigned)u) << 16); }
__device__ __forceinline__ float sigmoidf_(float x) { return __builtin_amdgcn_rcpf(1.0f + __expf(-x)); }
__device__ __forceinline__ float siluf_(float x) { return x * sigmoidf_(x); }
template <int CTRL> __device__ __forceinline__ float dpp_f(float v) { return __builtin_bit_cast(float, __builtin_amdgcn_update_dpp(0, __builtin_bit_cast(int, v), CTRL, 0xF, 0xF, true)); }
__device__ __forceinline__ float row16_sum(float v) {
    v += dpp_f<0xB1>(v);
    v += dpp_f<0x4E>(v);
    v += dpp_f<0x141>(v);
    v += dpp_f<0x140>(v);
    return v;
}
__device__ __forceinline__ float wave_sum(float v) {
    v = row16_sum(v);
    v += __shfl_xor(v, 16); v += __shfl_xor(v, 32);
    return v;
}
__device__ __forceinline__ float wave_max(float v) {
#pragma unroll
    for (int o = 1; o < 64; o <<= 1) v = fmaxf(v, __shfl_xor(v, o));
    return v;
}
__device__ __forceinline__ float logsigmoidf_(float z) { return fminf(z, 0.f) - __logf(1.0f + __expf(-fabsf(z))); }
__device__ __forceinline__ int opaque_tid() { int t = threadIdx.x; asm volatile("" : "+v"(t)); return t; }
#define MFMA16(a, b, c) __builtin_amdgcn_mfma_f32_16x16x32_bf16((a), (b), (c), 0, 0, 0)
__device__ __forceinline__ s16x4 tr_read(LAS unsigned char* p) { return __builtin_amdgcn_ds_read_tr16_b64_v4i16((LAS s16x4*)p); }
__device__ __forceinline__ bf16x8 cat4(s16x4 lo, s16x4 hi) { return __builtin_shufflevector(lo, hi, 0, 1, 2, 3, 4, 5, 6, 7); }

namespace pg8 {
constexpr int BM = 256, BK = 64, HALF = 128, HTB = HALF * BK * 2, STAGE_BYTES = 8 * HTB, NXCD = 8, WGM = 8;
__host__ __device__ __forceinline__ int lds_byte(int r, int c) { const int st = (r >> 4) * 2 + (c >> 5), rr = r & 15, cc = c & 31, ob = rr * 64 + cc * 2; return st * 1024 + (ob ^ (((ob >> 9) & 1) << 5)); }
__host__ __device__ __forceinline__ void stage_rc(int b, int& R, int& C) { const int st = b / 1024, sb = b % 1024, swz = sb ^ (((sb >> 9) & 1) << 5); R = (st >> 1) * 16 + swz / 64; C = (st & 1) * 32 + (swz % 64) / 2; }
__host__ __device__ __forceinline__ int perm32(int rho) { const int n = rho >> 4, i = rho & 15; return 8 * (i >> 2) + 4 * n + (i & 3); }

struct Unit { int pm, pn; };
struct Gemm { const bf16_t* A; const bf16_t* Bt; int lda, ldb, K; };

struct StaticOrder {
    int nM, nN, nwg, G, c;
    __host__ __device__ void init(int nM_, int nN_, int G_, int c_) { nM = nM_; nN = nN_; nwg = nM * nN; G = G_; c = c_; }
    __host__ __device__ bool next(int i, Unit& u) const {
        const long L = (long)i * G + c; if (L >= nwg) return false;
        int wgid = (int)L; { const int q = nwg / NXCD, r = nwg % NXCD, xcd = wgid % NXCD, off = wgid / NXCD; wgid = (xcd < r ? xcd * (q + 1) : r * (q + 1) + (xcd - r) * q) + off; }
        const int nig = WGM * nN, gid = wgid / nig, fm = gid * WGM, gsz = (nM - fm) < WGM ? (nM - fm) : WGM;
        u.pm = fm + ((wgid % nig) % gsz); u.pn = (wgid % nig) / gsz; return true;
    }
};

template <int MODE> struct Epi {
    static constexpr bool PERM = true;
    bf16_t* O; int ldc; const bf16_t* G; int ldg; float* F;
    __device__ __forceinline__ void operator()(const f32x4 (&acc)[2][2][4][2], const Unit& u, int wr, int wc, int fr, int fq) const {
        const int row0 = u.pm * BM + wr * 64 + fr; const int col0 = u.pn * BM + wc * 32 + 8 * fq;
#pragma unroll
        for (int ai = 0; ai < 2; ++ai)
#pragma unroll
            for (int m = 0; m < 4; ++m) {
                const size_t row = (size_t)(row0 + ai * HALF + m * 16);
#pragma unroll
                for (int bj = 0; bj < 2; ++bj) {
                    const int col = col0 + bj * HALF;
                    f32x4 v0 = acc[ai][bj][m][0], v1 = acc[ai][bj][m][1];
                    if (MODE == 1 || MODE == 2) {
                        const u32x4 g = *(const u32x4*)(G + row * ldg + col);
                        v0[0] *= sigmoidf_(bflo(g.x)); v0[1] *= sigmoidf_(bfhi(g.x)); v0[2] *= sigmoidf_(bflo(g.y)); v0[3] *= sigmoidf_(bfhi(g.y));
                        v1[0] *= sigmoidf_(bflo(g.z)); v1[1] *= sigmoidf_(bfhi(g.z)); v1[2] *= sigmoidf_(bflo(g.w)); v1[3] *= sigmoidf_(bfhi(g.w));
                    }
                    if (MODE == 5) {
                        const u32x4 ga = __builtin_nontemporal_load((const u32x4*)(G + row * ldg + col)), gb = __builtin_nontemporal_load((const u32x4*)(G + row * ldg + col + (UGB - UGA)));
                        const u32x4 o = *(const u32x4*)(O + row * ldc + col);
                        v0[0] = bflo(o.x) * sigmoidf_(bflo(ga.x)) + v0[0] * sigmoidf_(bflo(gb.x)); v0[1] = bfhi(o.x) * sigmoidf_(bfhi(ga.x)) + v0[1] * sigmoidf_(bfhi(gb.x));
                        v0[2] = bflo(o.y) * sigmoidf_(bflo(ga.y)) + v0[2] * sigmoidf_(bflo(gb.y)); v0[3] = bfhi(o.y) * sigmoidf_(bfhi(ga.y)) + v0[3] * sigmoidf_(bfhi(gb.y));
                        v1[0] = bflo(o.z) * sigmoidf_(bflo(ga.z)) + v1[0] * sigmoidf_(bflo(gb.z)); v1[1] = bfhi(o.z) * sigmoidf_(bfhi(ga.z)) + v1[1] * sigmoidf_(bfhi(gb.z));
                        v1[2] = bflo(o.w) * sigmoidf_(bflo(ga.w)) + v1[2] * sigmoidf_(bflo(gb.w)); v1[3] = bfhi(o.w) * sigmoidf_(bfhi(ga.w)) + v1[3] * sigmoidf_(bfhi(gb.w));
                    }
                    if (MODE == 2) {
                        const u32x4 o = *(const u32x4*)(O + row * ldc + col);
                        v0[0] += bflo(o.x); v0[1] += bfhi(o.x); v0[2] += bflo(o.y); v0[3] += bfhi(o.y);
                        v1[0] += bflo(o.z); v1[1] += bfhi(o.z); v1[2] += bflo(o.w); v1[3] += bfhi(o.w);
                    }
                    if (MODE == 3) {
                        const u32x4 p = *(const u32x4*)(O + row * ldc + col);
                        float* fp = F + row * ldc + col;
                        const u32x4 hb = *(const u32x4*)(G + row * ldg + col);
                        f32x4 h0 = {bflo(hb.x), bfhi(hb.x), bflo(hb.y), bfhi(hb.y)}, h1 = {bflo(hb.z), bfhi(hb.z), bflo(hb.w), bfhi(hb.w)};
                        h0[0] += bflo(p.x) * sigmoidf_(v0[0]); h0[1] += bfhi(p.x) * sigmoidf_(v0[1]); h0[2] += bflo(p.y) * sigmoidf_(v0[2]); h0[3] += bfhi(p.y) * sigmoidf_(v0[3]);
                        h1[0] += bflo(p.z) * sigmoidf_(v1[0]); h1[1] += bfhi(p.z) * sigmoidf_(v1[1]); h1[2] += bflo(p.w) * sigmoidf_(v1[2]); h1[3] += bfhi(p.w) * sigmoidf_(v1[3]);
                        *(f32x4*)fp = h0; *(f32x4*)(fp + 4) = h1;
                    } else {
                        u32x4 w; w.x = cvt_pk_bf16_asm(v0[0], v0[1]); w.y = cvt_pk_bf16_asm(v0[2], v0[3]); w.z = cvt_pk_bf16_asm(v1[0], v1[1]); w.w = cvt_pk_bf16_asm(v1[2], v1[3]);
                        if (MODE == 4) {
                            __builtin_nontemporal_store(w, (u32x4*)(O + row * ldc + col));
                            if (u.pn >= UDK / 256 && u.pn < (UDV + 1536) / 256 && u.pm < MP / 256) {
                                const int cc = col - UDK, s2 = cc >= 1536 ? 1 : 0, r = cc - s2 * 1536, gk = r >> 9, hd = r & 511;
                                const int win = 128 << (2 * gk), bb = (int)(row >> 12), i = (int)(row & 4095) - (4096 - win);
                                if (i >= 0) {
                                    float* dst = F + (gk == 0 ? O_KVP0 : (gk == 1 ? O_KVP1 : O_KVP2)) + ((size_t)(bb * win + i) * 2 + s2) * 512 + hd;
                                    __builtin_nontemporal_store(v0, (f32x4*)dst); __builtin_nontemporal_store(v1, (f32x4*)(dst + 4));
                                }
                            }
                        } else *(u32x4*)(O + row * ldc + col) = w;
                    }
                }
            }
    }
};

template <class EpiT, class Sched>
__device__ __forceinline__ void gemm_phase(LAS unsigned char* lds, const Gemm g, const Sched& S, const EpiT& E) {
    const int tid = threadIdx.x, wid = __builtin_amdgcn_readfirstlane(tid >> 6), lane = tid & 63, wr = wid >> 2, wc = wid & 3, fr = lane & 15, fq = lane >> 4;
    const int nt = g.K / BK;
    unsigned voffA[2], voffB[2];
#pragma unroll
    for (int i = 0; i < 2; ++i) { int R, C; stage_rc(tid * 16 + i * 8192, R, C); const int Rb = EpiT::PERM ? ((R & ~31) + perm32(R & 31)) : R;
        voffA[i] = (unsigned)(R * g.lda + C) * 2u; voffB[i] = (unsigned)(Rb * g.ldb + C) * 2u; }
    const size_t kstep = (size_t)(BK * 2);
    const size_t hstepA = (size_t)HALF * g.lda * 2, hstepB = (size_t)HALF * g.ldb * 2;
    const size_t tstepA = 2 * hstepA, tstepB = 2 * hstepB;
    const unsigned ldsw = (unsigned)wid * 1024u;
    const int aoff = lds_byte(wr * 64 + fr, fq * 8), boff = lds_byte(wc * 32 + fr, fq * 8);
#define PG8_SA(b, h) (((b) * 2 + (h)) * HTB)
#define PG8_SB(b, h) ((4 + (b) * 2 + (h)) * HTB)
#define PG8_STAGE(bufoff, gbase, voff) do { _Pragma("unroll") for (int _i = 0; _i < 2; ++_i) \
        __builtin_amdgcn_global_load_lds((const unsigned*)((const char*)(gbase) + (voff)[_i]), (LAS unsigned*)(lds + (bufoff) + ldsw + _i * 8192), 16, 0, 0); } while (0)
#define PG8_LDA(dst, b, h) do { _Pragma("unroll") for (int m = 0; m < 4; ++m) _Pragma("unroll") for (int k = 0; k < 2; ++k) dst[m][k] = *(const LAS bf16x8*)(lds + PG8_SA(b, h) + aoff + m * 2048 + k * 1024); } while (0)
#define PG8_LDB(dst, b, h) do { _Pragma("unroll") for (int n = 0; n < 2; ++n) _Pragma("unroll") for (int k = 0; k < 2; ++k) dst[n][k] = *(const LAS bf16x8*)(lds + PG8_SB(b, h) + boff + n * 2048 + k * 1024); } while (0)
#define PG8_MMA(ai, bj, At, Bt) do { __builtin_amdgcn_s_setprio(1); _Pragma("unroll") for (int m = 0; m < 4; ++m) _Pragma("unroll") for (int n = 0; n < 2; ++n) _Pragma("unroll") for (int k = 0; k < 2; ++k) \
        acc[ai][bj][m][n] = __builtin_amdgcn_mfma_f32_16x16x32_bf16(Bt[n][k], At[m][k], acc[ai][bj][m][n], 0, 0, 0); __builtin_amdgcn_s_setprio(0); } while (0)
#define PG8_WAIT_V(n) asm volatile("s_waitcnt vmcnt(" #n ")" ::: "memory")
#define PG8_WAIT_L(n) asm volatile("s_waitcnt lgkmcnt(" #n ")" ::: "memory")
#define PG8_BAR __builtin_amdgcn_s_barrier()
#define PG8_SCHED __builtin_amdgcn_sched_barrier(0)
    Unit cur, nxt; int ui = 0;
    if (!S.next(0, cur)) return;
    f32x4 acc[2][2][4][2];
#pragma unroll
    for (int a = 0; a < 2; ++a)
#pragma unroll
        for (int b = 0; b < 2; ++b)
#pragma unroll
            for (int m = 0; m < 4; ++m)
#pragma unroll
                for (int n = 0; n < 2; ++n) acc[a][b][m][n] = (f32x4){0.f, 0.f, 0.f, 0.f};
    bf16x8 At[4][2], B0[2][2], B1[2][2];
    const char* cA = (const char*)g.A + (size_t)cur.pm * tstepA; const char* cB = (const char*)g.Bt + (size_t)cur.pn * tstepB;
    PG8_STAGE(PG8_SB(0, 0), cB, voffB); PG8_STAGE(PG8_SB(0, 1), cB + hstepB, voffB); PG8_STAGE(PG8_SA(0, 0), cA, voffA); PG8_STAGE(PG8_SA(0, 1), cA + hstepA, voffA);
    if (wr == 1) PG8_BAR;
    PG8_WAIT_V(2); PG8_BAR;
    PG8_STAGE(PG8_SB(1, 0), cB + kstep, voffB); PG8_STAGE(PG8_SA(1, 0), cA + kstep, voffA); PG8_STAGE(PG8_SB(1, 1), cB + hstepB + kstep, voffB);
    PG8_WAIT_V(6); PG8_BAR;
    for (;;) {
        const bool has_next = S.next(ui + 1, nxt);
        const char* nA = has_next ? (const char*)g.A + (size_t)nxt.pm * tstepA : cA; const char* nB = has_next ? (const char*)g.Bt + (size_t)nxt.pn * tstepB : cB;
        for (int t = 0; t < nt; t += 2) {
            const bool last = (t == nt - 2);
            const char* a1 = cA + (size_t)(t + 1) * kstep;
            const char* a2 = last ? nA : cA + (size_t)(t + 2) * kstep; const char* b2 = last ? nB : cB + (size_t)(t + 2) * kstep;
            const char* a3 = a2 + kstep; const char* b3 = b2 + kstep;
            PG8_LDB(B0, 0, 0); PG8_LDB(B1, 0, 1); PG8_SCHED; PG8_LDA(At, 0, 0); PG8_STAGE(PG8_SA(1, 1), a1 + hstepA, voffA);
            PG8_WAIT_V(8); PG8_WAIT_L(0); PG8_BAR; PG8_MMA(0, 0, At, B0); PG8_MMA(0, 1, At, B1); PG8_BAR; PG8_SCHED;
            PG8_LDA(At, 0, 1); PG8_STAGE(PG8_SB(0, 0), b2, voffB); PG8_STAGE(PG8_SB(0, 1), b2 + hstepB, voffB); PG8_STAGE(PG8_SA(0, 0), a2, voffA);
            PG8_WAIT_V(8); PG8_WAIT_L(0); PG8_BAR; PG8_MMA(1, 0, At, B0); PG8_MMA(1, 1, At, B1); PG8_BAR; PG8_SCHED;
            PG8_LDB(B0, 1, 0); PG8_LDB(B1, 1, 1); PG8_SCHED; PG8_LDA(At, 1, 0); PG8_STAGE(PG8_SA(0, 1), a2 + hstepA, voffA);
            PG8_WAIT_V(8); PG8_WAIT_L(0); PG8_BAR; PG8_MMA(0, 0, At, B0); PG8_MMA(0, 1, At, B1); PG8_BAR; PG8_SCHED;
            PG8_LDA(At, 1, 1); PG8_STAGE(PG8_SB(1, 0), b3, voffB); PG8_STAGE(PG8_SB(1, 1), b3 + hstepB, voffB); PG8_STAGE(PG8_SA(1, 0), a3, voffA);
            PG8_WAIT_V(8); PG8_WAIT_L(0); PG8_BAR; PG8_MMA(1, 0, At, B0); PG8_MMA(1, 1, At, B1); PG8_BAR; PG8_SCHED;
        }
        if (wr == 0) PG8_BAR;
        E(acc, cur, wr, wc, fr, fq);
        if (!has_next) break;
#pragma unroll
        for (int a = 0; a < 2; ++a)
#pragma unroll
            for (int b = 0; b < 2; ++b)
#pragma unroll
                for (int m = 0; m < 4; ++m)
#pragma unroll
                    for (int n = 0; n < 2; ++n) acc[a][b][m][n] = (f32x4){0.f, 0.f, 0.f, 0.f};
        cur = nxt; cA = nA; cB = nB; ++ui;
        if (wr == 1) PG8_BAR;
    }
    PG8_WAIT_V(0);
    PG8_BAR;
#undef PG8_SA
#undef PG8_SB
#undef PG8_STAGE
#undef PG8_LDA
#undef PG8_LDB
#undef PG8_MMA
#undef PG8_WAIT_V
#undef PG8_WAIT_L
#undef PG8_BAR
#undef PG8_SCHED
}
}

#define XB_TMO      128
#define XB_XCNT(j)  (256  + 64 * (j))
#define XB_XSUB(j)  (1280 + 64 * (j))
#define XB_XGEN(j)  (2304 + 64 * (j))
#define XB_TOP      3328
#define XB_TOPGEN   3392
#define XCD_BAR_WORDS 3456
#define XB_SPIN_CAP (1u << 18)
__device__ __forceinline__ unsigned xb_ld(unsigned* p)              { return __hip_atomic_load(p, __ATOMIC_RELAXED, __HIP_MEMORY_SCOPE_AGENT); }
__device__ __forceinline__ unsigned xb_add(unsigned* p, unsigned v) { return __hip_atomic_fetch_add(p, v, __ATOMIC_RELAXED, __HIP_MEMORY_SCOPE_AGENT); }
__device__ __forceinline__ unsigned xb_xcc_id() { return (unsigned)__builtin_amdgcn_s_getreg((3 << 11) | 20) & 0xFu; }
#define XB_SPIN(cond, bar) do { unsigned _sp = 0; while (cond) { __builtin_amdgcn_s_sleep(1); \
    if ((++_sp & 255u) == 0u) { if (xb_ld(&(bar)[XB_TMO])) break; if (_sp > XB_SPIN_CAP) { atomicAdd(&(bar)[XB_TMO], 1u); break; } } } } while (0)
struct XcdBarrier { unsigned* bar; unsigned x; volatile LAS unsigned* st; };
__device__ __forceinline__ XcdBarrier xcd_barrier_post(unsigned* bar, volatile LAS unsigned* st) {
    XcdBarrier b; b.bar = bar; b.x = xb_xcc_id(); b.st = st;
    if (threadIdx.x == 0) (void)xb_add(&bar[XB_XCNT(b.x)], 1u);
    return b;
}
__device__ __forceinline__ void xcd_barrier_complete(unsigned* bar, unsigned x, unsigned& nloc, unsigned& nx) {
    const unsigned G = gridDim.x * gridDim.y * gridDim.z;
    unsigned sum, cnt, mine, sp = 0u;
    for (;;) {
        sum = 0u; cnt = 0u; mine = 0u;
#pragma unroll
        for (unsigned j = 0; j < 16; ++j) { const unsigned c = xb_ld(&bar[XB_XCNT(j)]); sum += c; cnt += (c > 0u) ? 1u : 0u; mine = (j == x) ? c : mine; }
        if (sum == G) break;
        __builtin_amdgcn_s_sleep(1);
        if ((++sp & 255u) == 0u) { if (xb_ld(&bar[XB_TMO])) break; if (sp > XB_SPIN_CAP) { atomicAdd(&bar[XB_TMO], 1u); break; } }
    }
    nloc = mine > 0u ? mine : 1u; nx = cnt > 0u ? cnt : 1u;
}
__device__ __forceinline__ void xcd_barrier(const XcdBarrier& b) {
    asm volatile("s_waitcnt vmcnt(0)" ::: "memory");
    __syncthreads();
    if (threadIdx.x == 0) {
        unsigned* bar = b.bar;
        __builtin_amdgcn_s_waitcnt(0);
        unsigned nloc = b.st[0], nx = b.st[1];
        if (nloc == 0u) { xcd_barrier_complete(bar, b.x, nloc, nx); b.st[0] = nloc; b.st[1] = nx; }
        const unsigned old = xb_add(&bar[XB_XSUB(b.x)], 1u);
        const unsigned gen = old / nloc;
        if (old + 1u == (gen + 1u) * nloc) {
            __builtin_amdgcn_fence(__ATOMIC_RELEASE, "agent");
            asm volatile("s_waitcnt vmcnt(0)" ::: "memory");
            const unsigned og = xb_add(&bar[XB_TOP], 1u);
            const unsigned tg = og / nx;
            if (og + 1u == (tg + 1u) * nx) xb_add(&bar[XB_TOPGEN], 1u);
            else XB_SPIN(xb_ld(&bar[XB_TOPGEN]) == tg, bar);
            __builtin_amdgcn_fence(__ATOMIC_ACQUIRE, "agent");
            xb_add(&bar[XB_XGEN(b.x)], 1u);
            asm volatile("s_waitcnt vmcnt(0)" ::: "memory");
        } else {
            XB_SPIN(xb_ld(&bar[XB_XGEN(b.x)]) == gen, bar);
            __builtin_amdgcn_fence(__ATOMIC_ACQUIRE, "agent");
            asm volatile("s_waitcnt vmcnt(0)" ::: "memory");
        }
    }
    __syncthreads();
}

struct Args { const float* in[19]; float* out; unsigned char* ws; int ph_lo, ph_hi; };

__device__ __forceinline__ void transpose_item(const float* W, int ldw, int k0, int nsrc0, bf16_t* WT, int ldt, int dst_row0, int dst_k0, LAS float* scr, int lane) {
#pragma unroll 8
    for (int i = 0; i < 32; ++i) { const int kk = 2 * i + (lane >> 5); scr[kk * 33 + (lane & 31)] = W[(size_t)(k0 + kk) * ldw + nsrc0 + (lane & 31)]; }
    __builtin_amdgcn_fence(__ATOMIC_RELEASE, "wavefront"); asm volatile("s_waitcnt lgkmcnt(0)" ::: "memory");
    const int c = lane & 7;
#pragma unroll
    for (int j = 0; j < 4; ++j) { const int n = (lane >> 3) + 8 * j; const LAS float* s = scr + (8 * c) * 33 + n;
        u32x4 o; o.x = cvt_pk_bf16(s[0 * 33], s[1 * 33]); o.y = cvt_pk_bf16(s[2 * 33], s[3 * 33]); o.z = cvt_pk_bf16(s[4 * 33], s[5 * 33]); o.w = cvt_pk_bf16(s[6 * 33], s[7 * 33]);
        *(u32x4*)(WT + (size_t)(dst_row0 + n) * ldt + dst_k0 + k0 + 8 * c) = o; }
    asm volatile("s_waitcnt lgkmcnt(0)" ::: "memory");
}

constexpr unsigned CP_PERB = 2040u * 256u, CP_TOT = CP_PERB * 32u;
constexpr unsigned CP_S1 = 3000000u, CP_S2 = 8000000u, CP_S3 = 12000000u, CP_S4 = 15000000u;
static_assert(CP_S4 <= CP_TOT, "slices within the copy");
__device__ __forceinline__ void copy_g2_range(const Args& a, unsigned lo, unsigned hi, int sb, int nsb) {
    const unsigned T = (unsigned)nsb * 512u, t0 = lo + (unsigned)sb * 512u + threadIdx.x;
    const f32x4* __restrict__ src = (const f32x4*)a.in[5]; f32x4* __restrict__ dst = (f32x4*)(a.out + O_KVS2);
    for (unsigned i0 = t0; i0 < hi; i0 += 16u * T) {
        f32x4 v[16];
#pragma unroll
        for (int u = 0; u < 16; ++u) { const unsigned i = i0 + u * T; if (i < hi) { const unsigned bb = i / CP_PERB, o = i - bb * CP_PERB; v[u] = __builtin_nontemporal_load(src + (size_t)bb * (2048u * 256u) + 2048u + o); } }
#pragma unroll
        for (int u = 0; u < 16; ++u) { const unsigned i = i0 + u * T; if (i < hi) { const unsigned bb = i / CP_PERB, o = i - bb * CP_PERB; __builtin_nontemporal_store(v[u], dst + (size_t)bb * (2048u * 256u) + o); } }
    }
}
__device__ __forceinline__ void p0_prologue(const Args& a, LAS unsigned char* lds) {
    const int tid = threadIdx.x, lane = tid & 63, wave = __builtin_amdgcn_readfirstlane(tid >> 6);
    const int G = gridDim.x, gw = blockIdx.x * 8 + wave, NGW = G * 8;
    unsigned char* ws = a.ws;
    LAS float* WGL = (LAS float*)lds;
    const float* w_in = a.in[10];
    for (int e = tid; e < 16384; e += 512) { const int k = e >> 4, r = e & 15; WGL[r * 1028 + k] = w_in[(size_t)k * WIN_W + 3072 + r]; }
    __syncthreads();
    {
        const float* g_pre = a.in[8];
        f32x4 gp[4];
#pragma unroll
        for (int j = 0; j < 4; ++j) gp[j] = *(const f32x4*)(g_pre + 4 * lane + 256 * j);
        bf16_t* XN = (bf16_t*)(ws + WS_XN); float* GLR = (float*)(ws + WS_GLR);
        f32x4 vn[4];
        if (gw < M) { const float* xr = (gw < MP) ? a.in[0] + (size_t)gw * DM : a.in[1] + (size_t)(gw - MP) * DM;
#pragma unroll
            for (int j = 0; j < 4; ++j) vn[j] = *(const f32x4*)(xr + 4 * lane + 256 * j); }
        for (int m = gw; m < M; m += NGW) {
            f32x4 v[4]; float ss = 0.f;
#pragma unroll
            for (int j = 0; j < 4; ++j) { v[j] = vn[j]; ss += (v[j].x * v[j].x + v[j].y * v[j].y) + (v[j].z * v[j].z + v[j].w * v[j].w); }
            { const int mn = m + NGW; if (mn < M) { const float* xr = (mn < MP) ? a.in[0] + (size_t)mn * DM : a.in[1] + (size_t)(mn - MP) * DM;
#pragma unroll
                for (int j = 0; j < 4; ++j) vn[j] = *(const f32x4*)(xr + 4 * lane + 256 * j); } }
            const float rs = rsqrtf(wave_sum(ss) * (1.f / DM) + NORM_EPS);
#pragma unroll
            for (int j = 0; j < 4; ++j) { v[j] = v[j] * rs * gp[j];
                u32x2 o; o.x = cvt_pk_bf16(v[j].x, v[j].y); o.y = cvt_pk_bf16(v[j].z, v[j].w);
                *(u32x2*)(XN + (size_t)m * DM + 4 * lane + 256 * j) = o; }
            float mine = 0.f;
#pragma unroll 2
            for (int r = 0; r < 16; ++r) {
                float p = 0.f;
#pragma unroll
                for (int j = 0; j < 4; ++j) { const f32x4 w4 = *(const LAS f32x4*)(WGL + r * 1028 + 4 * lane + 256 * j); p += (v[j].x * w4.x + v[j].y * w4.y) + (v[j].z * w4.z + v[j].w * w4.w); }
                p = row16_sum(p);
                if ((lane & 15) == r) mine = p;
            }
            mine += __shfl_xor(mine, 16); mine += __shfl_xor(mine, 32);
            if (lane < 16) GLR[(size_t)m * 16 + lane] = mine;
        }
    }
    __syncthreads();
    {
        LAS float* scr = (LAS float*)(lds + 65792 + wave * 8448);
        constexpr int I_IN = 16 * 320, I_GA = 16 * 32, I_DB = 8 * 32, I_O = 16 * 32, I_G = 16 * 32, I_P = 4 * 32;
        constexpr int NIT = I_IN + I_GA + I_DB + I_O + I_G + I_P;
        for (int it = gw; it < NIT; it += NGW) {
            int r = it;
            if (r < I_IN) { const int kb = r / 320, nb = r % 320, nd = 32 * nb; transpose_item(w_in, WIN_W, 64 * kb, nd + (nd >= 3072 ? 16 : 0), (bf16_t*)(ws + WS_WIN), 1024, nd, 0, scr, lane); continue; } r -= I_IN;
            if (r < I_GA) { const int kb = r / 32, nb = r % 32; transpose_item(a.in[14], 1024, 64 * kb, 32 * nb, (bf16_t*)(ws + WS_WAB), 1536, 32 * nb, 0, scr, lane); continue; } r -= I_GA;
            if (r < I_DB) { const int kb = r / 32, nb = r % 32; transpose_item(a.in[15], 1024, 64 * kb, 32 * nb, (bf16_t*)(ws + WS_WAB), 1536, 32 * nb, 1024, scr, lane); continue; } r -= I_DB;
            if (r < I_O) { const int kb = r / 32, nb = r % 32; transpose_item(a.in[16], 1024, 64 * kb, 32 * nb, (bf16_t*)(ws + WS_WO), 1024, 32 * nb, 0, scr, lane); continue; } r -= I_O;
            if (r < I_G) { const int kb = r / 32, nb = r % 32; transpose_item(a.in[18], 1024, 64 * kb, 32 * nb, (bf16_t*)(ws + WS_WG), 1024, 32 * nb, 0, scr, lane); continue; } r -= I_G;
            { const int kb = r / 32, nb = r % 32; transpose_item(a.in[17], 1024, 64 * kb, 32 * nb, (bf16_t*)(ws + WS_WP), 256, 32 * nb, 0, scr, lane); }
        }
    }
    {
        u32x2* __restrict__ PE = (u32x2*)(ws + WS_PE);
        const size_t n4 = (size_t)M * 256 / 4, np4 = (size_t)MP * 256 / 4;
        const f32x4* __restrict__ p0 = (const f32x4*)a.in[6]; const f32x4* __restrict__ p1 = (const f32x4*)a.in[7];
        const size_t T = (size_t)G * 512, t0 = (size_t)blockIdx.x * 512 + tid;
        for (size_t i0 = t0; i0 < n4; i0 += 8 * T) {
            f32x4 v[8];
#pragma unroll
            for (int u = 0; u < 8; ++u) { const size_t i = i0 + u * T; if (i < n4) v[u] = (i < np4) ? p0[i] : p1[i - np4]; }
#pragma unroll
            for (int u = 0; u < 8; ++u) { const size_t i = i0 + u * T; if (i < n4) { u32x2 o; o.x = cvt_pk_bf16(v[u].x, v[u].y); o.y = cvt_pk_bf16(v[u].z, v[u].w); PE[i] = o; } }
        }
    }
    copy_g2_range(a, (G == 256) ? CP_S4 : 0u, CP_TOT, blockIdx.x, G);
    {
        const unsigned T = (unsigned)G * 512u, t0 = (unsigned)blockIdx.x * 512u + tid;
#pragma unroll
        for (int g = 1; g >= 0; --g) {
            const unsigned Lb = (g == 0) ? 128u : 512u;
            const f32x4* __restrict__ src = (const f32x4*)a.in[3 + g]; f32x4* __restrict__ dst = (f32x4*)(a.out + (g == 0 ? O_KVS0 : O_KVS1));
            const unsigned per_b = (Lb - 8u) * 256u, tot = per_b * (unsigned)DECB;
            for (unsigned i0 = t0; i0 < tot; i0 += 16u * T) {
                f32x4 v[16];
#pragma unroll
                for (int u = 0; u < 16; ++u) { const unsigned i = i0 + u * T; if (i < tot) { const unsigned bb = i / per_b, o = i - bb * per_b; v[u] = __builtin_nontemporal_load(src + (size_t)bb * (Lb * 256u) + 2048u + o); } }
#pragma unroll
                for (int u = 0; u < 16; ++u) { const unsigned i = i0 + u * T; if (i < tot) { const unsigned bb = i / per_b, o = i - bb * per_b; __builtin_nontemporal_store(v[u], dst + (size_t)bb * (Lb * 256u) + o); } }
            }
        }
    }
}

constexpr int KST = 272, VSA = 288;
static_assert(256 * KST + 256 * VSA <= LDS_BYTES - 32, "attention tiles fit under the control words");
constexpr int KST_DUMMY = 0;
struct AttnHalf { u32x4 k[4], v[4]; };
__device__ __forceinline__ void ah_issue(AttnHalf& H, const bf16_t* U, size_t rowbase, int dil, int lbase, int colk, int colv, int tid) {
#pragma unroll
    for (int i = 0; i < 4; ++i) {
        const int c = tid + 512 * i, row = c >> 4, ch = c & 15, l = lbase + row;
        if (l >= 0) { const bf16_t* p = U + (rowbase + (size_t)l * dil) * NU + 8 * ch; H.k[i] = *(const u32x4*)(p + colk); H.v[i] = *(const u32x4*)(p + colv); }
        else { H.k[i] = (u32x4){0u, 0u, 0u, 0u}; H.v[i] = (u32x4){0u, 0u, 0u, 0u}; }
    }
}
__device__ __forceinline__ void ah_store(LAS unsigned char* lds, const AttnHalf& H, int half, int tid) {
    LAS unsigned char* Ks = lds; LAS unsigned char* Vs = lds + 256 * KST;
#pragma unroll
    for (int i = 0; i < 4; ++i) { const int c = tid + 512 * i, row = half * 128 + (c >> 4), ch = c & 15; *(LAS u32x4*)(Ks + row * KST + 16 * ch) = H.k[i]; *(LAS u32x4*)(Vs + row * VSA + 16 * ch) = H.v[i]; }
}
__device__ __forceinline__ void attn_block(LAS unsigned char* lds, const bf16x8 (&qf)[4], bf16_t* OG, float* LSE, int g, int h, size_t rowbase, int dil, int l0, int hp, int tid) {
    const int lane = tid & 63, w = __builtin_amdgcn_readfirstlane(tid >> 6), qi = lane & 15, gq = lane >> 4;
    LAS unsigned char* Ks = lds; LAS unsigned char* Vs = lds + 256 * KST;
    const int lq = l0 + 16 * w + qi;
    const size_t mq = rowbase + (size_t)lq * dil;
    int trow[10];
#pragma unroll
    for (int t = 0; t < 10; ++t) { const int lt = w + (t < 9 ? t : 8); trow[t] = (((lt >> 3) ? (hp ^ 1) : hp) << 7) + ((lt & 7) << 4); }
    f32x4 sc[9];
#pragma unroll
    for (int kt = 0; kt < 9; ++kt) {
        f32x4 acc = {0.f, 0.f, 0.f, 0.f};
#pragma unroll
        for (int s = 0; s < 4; ++s) { const bf16x8 ka = *(const LAS bf16x8*)(Ks + (trow[kt] + qi) * KST + 64 * s + 16 * gq); acc = MFMA16(ka, qf[s], acc); }
        sc[kt] = acc;
    }
    float mx = -INFINITY;
#pragma unroll
    for (int kt = 0; kt < 9; ++kt)
#pragma unroll
        for (int jj = 0; jj < 4; ++jj) {
            const int diff = 128 + qi - 16 * kt - 4 * gq - jj; const bool valid = (diff >= 0) && (diff <= 128) && (lq - diff >= 0);
            const float s = valid ? sc[kt][jj] * QSCALE : -INFINITY; sc[kt][jj] = s; mx = fmaxf(mx, s);
        }
    mx = fmaxf(mx, __shfl_xor(mx, 16)); mx = fmaxf(mx, __shfl_xor(mx, 32));
    float sum = 0.f;
#pragma unroll
    for (int kt = 0; kt < 9; ++kt)
#pragma unroll
        for (int jj = 0; jj < 4; ++jj) { const float p = __expf(sc[kt][jj] - mx); sc[kt][jj] = p; sum += p; }
    sum += __shfl_xor(sum, 16); sum += __shfl_xor(sum, 32);
    const float inv = 1.0f / sum;
    bf16x8 pf[5];
#pragma unroll
    for (int a = 0; a < 5; ++a) {
        u32x4 t; t.x = cvt_pk_bf16(sc[2 * a][0], sc[2 * a][1]); t.y = cvt_pk_bf16(sc[2 * a][2], sc[2 * a][3]);
        if (a < 4) { t.z = cvt_pk_bf16(sc[2 * a + 1][0], sc[2 * a + 1][1]); t.w = cvt_pk_bf16(sc[2 * a + 1][2], sc[2 * a + 1][3]); } else { t.z = 0u; t.w = 0u; }
        pf[a] = __builtin_bit_cast(bf16x8, t);
    }
    const int q4 = qi >> 2, p4 = qi & 3;
    bf16_t* og = OG + ((size_t)g * M + mq) * 512 + h * 128 + 4 * gq;
#pragma unroll
    for (int c = 0; c < 8; ++c) {
        f32x4 o = {0.f, 0.f, 0.f, 0.f};
#pragma unroll
        for (int a = 0; a < 5; ++a) {
            const int r0 = trow[2 * a] + 4 * gq + q4, r1 = trow[2 * a + 1] + 4 * gq + q4;
            const s16x4 lo = tr_read(Vs + r0 * VSA + 32 * c + 8 * p4), hi = tr_read(Vs + r1 * VSA + 32 * c + 8 * p4);
            o = MFMA16(cat4(lo, hi), pf[a], o);
        }
        u32x2 st; st.x = cvt_pk_bf16(o[0] * inv, o[1] * inv); st.y = cvt_pk_bf16(o[2] * inv, o[3] * inv);
        *(u32x2*)(og + 16 * c) = st;
    }
    if (gq == 0) LSE[((size_t)g * M + mq) * 4 + h] = mx + __logf(sum);
}
constexpr int ATT_ITEMS = 768;
__device__ __forceinline__ void attn_prompt_item(LAS unsigned char* lds, const bf16_t* U, bf16_t* OG, float* LSE, int item) {
    const int tid = opaque_tid(), lane = tid & 63, w = __builtin_amdgcn_readfirstlane(tid >> 6), qi = lane & 15, gq = lane >> 4;
    int g, bh, cls, qb0, nst;
    if (item < 256) { bh = item >> 3; const int r = item & 7; if (r < 4) { g = 0; cls = 0; qb0 = 8 * r; } else { g = 1; cls = r - 4; qb0 = 0; } nst = 8; }
    else { const int i2 = item - 256; bh = i2 >> 4; g = 2; cls = i2 & 15; qb0 = 0; nst = 2; }
    const int h = bh & 3, b = bh >> 2, dil = 1 << (2 * g);
    const size_t rowbase = (size_t)b * SEQ + cls;
    const int colk = UDK + g * 512 + h * 128, colv = UDV + g * 512 + h * 128, colq = UDQ + g * 512 + h * 128;
    AttnHalf H;
    bf16x8 qf[4], qn[4];
    int l0 = qb0 * 128;
    {
        AttnHalf P;
        ah_issue(P, U, rowbase, dil, l0 - 128, colk, colv, tid);
        ah_issue(H, U, rowbase, dil, l0, colk, colv, tid);
        const size_t mq = rowbase + (size_t)(l0 + 16 * w + qi) * dil;
#pragma unroll
        for (int s = 0; s < 4; ++s) qf[s] = *(const bf16x8*)(U + mq * NU + colq + 32 * s + 8 * gq);
        ah_store(lds, P, 0, tid);
        ah_store(lds, H, 1, tid);
    }
    __syncthreads();
    for (int st = 0; st < nst; ++st) {
        const int hp = st & 1;
        const bool more = (st + 1 < nst);
        if (more) {
            ah_issue(H, U, rowbase, dil, l0 + 128, colk, colv, tid);
            const size_t mq = rowbase + (size_t)(l0 + 128 + 16 * w + qi) * dil;
#pragma unroll
            for (int s = 0; s < 4; ++s) qn[s] = *(const bf16x8*)(U + mq * NU + colq + 32 * s + 8 * gq);
        }
        attn_block(lds, qf, OG, LSE, g, h, rowbase, dil, l0, hp, tid);
        __syncthreads();
        if (more) {
            ah_store(lds, H, hp, tid);
#pragma unroll
            for (int s = 0; s < 4; ++s) qf[s] = qn[s];
            l0 += 128;
            __syncthreads();
        }
    }
}

constexpr int GP_QI = 0, GP_KD = 17408, GP_VV = 34816, GP_PS = 68608, GP_GL = 72704;
constexpr int VST2 = 528, VST = 144;
constexpr int PRE_CH = 4;
#define GP_LOAD(cc_) do { const size_t m0_ = (size_t)b * SEQ + (size_t)(cc_) * 64; \
    _Pragma("unroll") for (int jj = 0; jj < 8; ++jj) { const bf16_t* p = U + (m0_ + 8 * w + jj) * NU + h * 128 + 2 * lane; qn[jj] = __builtin_nontemporal_load((const unsigned*)(p + UQ)); kn[jj] = __builtin_nontemporal_load((const unsigned*)(p + UK)); } \
    _Pragma("unroll") for (int i = 0; i < 4; ++i) { const int ci = tid + 512 * i, row = ci >> 5, ch = ci & 31; vn[i] = *(const u32x4*)(U + (m0_ + row) * NU + UV + h * 256 + 8 * ch); } \
    gn = *(const f32x4*)(GLR + (m0_ + ((tid & 255) >> 2)) * 16 + 4 * (tid & 3)); } while (0)
__device__ __forceinline__ void gla_pre_item(LAS unsigned char* lds, const bf16_t* U, const float* GLR, const float* w_lr, const float* b_lr, bf16_t* QIN, bf16_t* KEND, float* DEC, bf16_t* OA, int item) {
    const int tid = opaque_tid(), lane = tid & 63, w = __builtin_amdgcn_readfirstlane(tid >> 6), qi = lane & 15, gq = lane >> 4, q4 = qi >> 2, p4 = qi & 3;
    const int c4 = item & (64 / PRE_CH - 1), h = (item / (64 / PRE_CH)) & 3, b = item / (256 / PRE_CH);
    float W0[16], W1[16];
    const int d0 = h * 128 + 2 * lane;
#pragma unroll
    for (int r = 0; r < 16; ++r) { const f32x2 t = *(const f32x2*)(w_lr + r * 512 + d0); W0[r] = t.x; W1[r] = t.y; }
    const f32x2 bias = *(const f32x2*)(b_lr + d0);
    LAS float* PS = (LAS float*)(lds + GP_PS); LAS float* GL = (LAS float*)(lds + GP_GL);
    const int it = w & 3, eh = w >> 2;
    unsigned qn[8], kn[8]; u32x4 vn[4]; f32x4 gn;
    GP_LOAD(c4 * PRE_CH);
    for (int cc = 0; cc < PRE_CH; ++cc) {
        const int c = c4 * PRE_CH + cc;
        const size_t m0 = (size_t)b * SEQ + c * 64;
        unsigned qv[8], kv[8];
#pragma unroll
        for (int jj = 0; jj < 8; ++jj) { qv[jj] = qn[jj]; kv[jj] = kn[jj]; }
#pragma unroll
        for (int i = 0; i < 4; ++i) { const int ci = tid + 512 * i, row = ci >> 5, ch = ci & 31; *(LAS u32x4*)(lds + GP_VV + row * VST2 + 16 * ch) = vn[i]; }
        *(LAS f32x4*)(GL + ((tid & 255) >> 2) * 16 + 4 * (tid & 3)) = gn;
        __syncthreads();
        GP_LOAD((cc + 1 < PRE_CH) ? c + 1 : c);
        float c0[8], c1[8]; float run0 = 0.f, run1 = 0.f;
#pragma unroll
        for (int jj = 0; jj < 8; ++jj) {
            const LAS float* gp = GL + (8 * w + jj) * 16;
            float z0 = bias.x, z1 = bias.y;
#pragma unroll
            for (int r4 = 0; r4 < 4; ++r4) { const f32x4 g4 = *(const LAS f32x4*)(gp + 4 * r4);
                z0 += g4.x * W0[4 * r4] + g4.y * W0[4 * r4 + 1] + g4.z * W0[4 * r4 + 2] + g4.w * W0[4 * r4 + 3];
                z1 += g4.x * W1[4 * r4] + g4.y * W1[4 * r4 + 1] + g4.z * W1[4 * r4 + 2] + g4.w * W1[4 * r4 + 3]; }
            run0 += logsigmoidf_(z0) * (1.f / 16.f); run1 += logsigmoidf_(z1) * (1.f / 16.f); c0[jj] = run0; c1[jj] = run1;
        }
        *(LAS f32x2*)(PS + w * 128 + 2 * lane) = (f32x2){run0, run1};
        __syncthreads();
        float off0 = 0.f, off1 = 0.f, tot0 = 0.f, tot1 = 0.f;
#pragma unroll
        for (int ww = 0; ww < 8; ++ww) { const f32x2 t = *(const LAS f32x2*)(PS + ww * 128 + 2 * lane); if (ww < w) { off0 += t.x; off1 += t.y; } tot0 += t.x; tot1 += t.y; }
        if (w == 0) *(f32x2*)(DEC + ((size_t)(b * 64 + c)) * 512 + h * 128 + 2 * lane) = (f32x2){__expf(tot0), __expf(tot1)};
#pragma unroll
        for (int jj = 0; jj < 8; ++jj) {
            const float b0 = off0 + c0[jj], b1 = off1 + c1[jj];
            const float q0 = bflo(qv[jj]), q1 = bfhi(qv[jj]), k0 = bflo(kv[jj]), k1 = bfhi(kv[jj]);
            const int ro = (8 * w + jj) * KST + 4 * lane;
            const unsigned qin = cvt_pk_bf16(q0 * __expf(b0) * QSCALE, q1 * __expf(b1) * QSCALE);
            *(LAS unsigned*)(lds + GP_QI + ro) = qin;
            *(LAS unsigned*)(lds + GP_KD + ro) = cvt_pk_bf16(k0 * __expf(-b0), k1 * __expf(-b1));
            const size_t go = (m0 + 8 * w + jj) * 512 + h * 128 + 2 * lane;
            *(unsigned*)(QIN + go) = qin;
            *(unsigned*)(KEND + go) = cvt_pk_bf16(k0 * __expf(tot0 - b0), k1 * __expf(tot1 - b1));
        }
        __syncthreads();
        bf16x8 qf[4];
#pragma unroll
        for (int s = 0; s < 4; ++s) qf[s] = *(const LAS bf16x8*)(lds + GP_QI + (16 * it + qi) * KST + 64 * s + 16 * gq);
        f32x4 at[4];
#pragma unroll
        for (int jt = 0; jt < 4; ++jt) {
            f32x4 acc = {0.f, 0.f, 0.f, 0.f};
            if (jt <= it) {
#pragma unroll
                for (int s = 0; s < 4; ++s) { const bf16x8 ka = *(const LAS bf16x8*)(lds + GP_KD + (16 * jt + qi) * KST + 64 * s + 16 * gq); acc = MFMA16(ka, qf[s], acc); }
#pragma unroll
                for (int jj = 0; jj < 4; ++jj) if (16 * jt + 4 * gq + jj > 16 * it + qi) acc[jj] = 0.f;
            }
            at[jt] = acc;
        }
        bf16x8 pf[2];
#pragma unroll
        for (int a = 0; a < 2; ++a) { u32x4 t; t.x = cvt_pk_bf16(at[2 * a][0], at[2 * a][1]); t.y = cvt_pk_bf16(at[2 * a][2], at[2 * a][3]); t.z = cvt_pk_bf16(at[2 * a + 1][0], at[2 * a + 1][1]); t.w = cvt_pk_bf16(at[2 * a + 1][2], at[2 * a + 1][3]); pf[a] = __builtin_bit_cast(bf16x8, t); }
#pragma unroll
        for (int e8 = 0; e8 < 8; ++e8) {
            const int et = 8 * eh + e8;
            f32x4 o = {0.f, 0.f, 0.f, 0.f};
#pragma unroll
            for (int a = 0; a < 2; ++a) {
                const int r0 = 32 * a + 4 * gq + q4;
                const s16x4 lo = tr_read(lds + GP_VV + r0 * VST2 + 32 * et + 8 * p4), hi = tr_read(lds + GP_VV + (r0 + 16) * VST2 + 32 * et + 8 * p4);
                o = MFMA16(cat4(lo, hi), pf[a], o);
            }
            u32x2 st; st.x = cvt_pk_bf16(o[0], o[1]); st.y = cvt_pk_bf16(o[2], o[3]);
            *(u32x2*)(OA + (m0 + 16 * it + qi) * 1024 + h * 256 + 16 * et + 4 * gq) = st;
        }
        __syncthreads();
    }
}
#undef GP_LOAD

constexpr int GC_QI = 0, GC_KE = 17408, GC_VV = 34816, GC_DE = 44032, GC_BUF = 44544, GC_ST = 2 * GC_BUF;
#define GC_LOAD(cc, S) do { const size_t m0_ = (size_t)b * SEQ + (cc) * 64; \
    _Pragma("unroll") for (int i_ = 0; i_ < 2; ++i_) { const int ci_ = tid + 512 * i_, row_ = ci_ >> 4, ch_ = ci_ & 15; const size_t go_ = (m0_ + row_) * 512 + h * 128 + 8 * ch_; rq[S][i_] = *(const u32x4*)(QIN + go_); rk[S][i_] = *(const u32x4*)(KEND + go_); } \
    rv[S] = *(const u32x4*)(U + (m0_ + (tid >> 3)) * NU + UV + h * 256 + sl * 64 + 8 * (tid & 7)); \
    rd[S] = (tid < 128) ? DEC[((size_t)(b * 64 + (cc))) * 512 + h * 128 + tid] : 0.f; \
    { const bf16_t* op_ = OA + (m0_ + 16 * it + qi) * 1024 + h * 256 + sl * 64 + 32 * eh + 4 * gq; ro[S][0] = *(const u32x2*)op_; ro[S][1] = *(const u32x2*)(op_ + 16); } } while (0)
#define GC_STORE(bufo, S) do { \
    _Pragma("unroll") for (int i_ = 0; i_ < 2; ++i_) { const int ci_ = tid + 512 * i_, row_ = ci_ >> 4, ch_ = ci_ & 15; *(LAS u32x4*)(lds + (bufo) + GC_QI + row_ * KST + 16 * ch_) = rq[S][i_]; *(LAS u32x4*)(lds + (bufo) + GC_KE + row_ * KST + 16 * ch_) = rk[S][i_]; } \
    *(LAS u32x4*)(lds + (bufo) + GC_VV + (tid >> 3) * VST + 16 * (tid & 7)) = rv[S]; \
    if (tid < 128) *(LAS float*)(lds + (bufo) + GC_DE + 4 * tid) = rd[S]; } while (0)
__device__ __forceinline__ void gla_chain_item(LAS unsigned char* lds, const bf16_t* U, const bf16_t* QIN, const bf16_t* KEND, const float* DEC, bf16_t* OA, float* state_out, int item) {
    const int tid = opaque_tid(), lane = tid & 63, w = __builtin_amdgcn_readfirstlane(tid >> 6), qi = lane & 15, gq = lane >> 4, q4 = qi >> 2, p4 = qi & 3;
    const int sl = item & 3, h = (item >> 2) & 3, b = item >> 4;
    const int it = w & 3, eh = w >> 2;
    f32x4 accS[4];
#pragma unroll
    for (int et = 0; et < 4; ++et) accS[et] = (f32x4){0.f, 0.f, 0.f, 0.f};
    for (int i = tid; i < 17408 / 4; i += 512) ((LAS unsigned*)(lds + GC_ST))[i] = 0u;
    u32x4 rq[4][2], rk[4][2], rv[4]; float rd[4]; u32x2 ro[4][2];
    GC_LOAD(0, 0); GC_LOAD(1, 1); GC_LOAD(2, 2);
    GC_STORE(0, 0);
    __syncthreads();
    for (int c4 = 0; c4 < 64; c4 += 4) {
#pragma unroll
        for (int k = 0; k < 4; ++k) {
            const int c = c4 + k;
            const int bo = (k & 1) * GC_BUF;
            const size_t m0 = (size_t)b * SEQ + c * 64;
            if (c + 3 < 64) GC_LOAD(c + 3, (k + 3) & 3);
            bf16_t* op = OA + (m0 + 16 * it + qi) * 1024 + h * 256 + sl * 64 + 32 * eh + 4 * gq;
            bf16x8 qf[4];
#pragma unroll
            for (int s = 0; s < 4; ++s) qf[s] = *(const LAS bf16x8*)(lds + bo + GC_QI + (16 * it + qi) * KST + 64 * s + 16 * gq);
#pragma unroll
            for (int e2 = 0; e2 < 2; ++e2) {
                const int et = 2 * eh + e2;
                const u32x2 oi = ro[k][e2];
                f32x4 o = {bflo(oi.x), bfhi(oi.x), bflo(oi.y), bfhi(oi.y)};
#pragma unroll
                for (int s = 0; s < 4; ++s) { const bf16x8 sa = *(const LAS bf16x8*)(lds + GC_ST + (16 * et + qi) * KST + 64 * s + 16 * gq); o = MFMA16(sa, qf[s], o); }
                u32x2 st; st.x = cvt_pk_bf16(o[0], o[1]); st.y = cvt_pk_bf16(o[2], o[3]);
                *(u32x2*)(op + 16 * e2) = st;
            }
            {
                const f32x4 dec = *(const LAS f32x4*)(lds + bo + GC_DE + 4 * (16 * w + 4 * gq));
#pragma unroll
                for (int et = 0; et < 4; ++et) accS[et] = accS[et] * dec;
#pragma unroll
                for (int a = 0; a < 2; ++a) {
                    const int r0 = 32 * a + 8 * gq + q4;
                    const bf16x8 ka = cat4(tr_read(lds + bo + GC_KE + r0 * KST + 32 * w + 8 * p4), tr_read(lds + bo + GC_KE + (r0 + 4) * KST + 32 * w + 8 * p4));
#pragma unroll
                    for (int et = 0; et < 4; ++et) {
                        const bf16x8 vb = cat4(tr_read(lds + bo + GC_VV + r0 * VST + 32 * et + 8 * p4), tr_read(lds + bo + GC_VV + (r0 + 4) * VST + 32 * et + 8 * p4));
                        accS[et] = MFMA16(ka, vb, accS[et]);
                    }
                }
            }
            __syncthreads();
#pragma unroll
            for (int et = 0; et < 4; ++et) { u32x2 st; st.x = cvt_pk_bf16(accS[et][0], accS[et][1]); st.y = cvt_pk_bf16(accS[et][2], accS[et][3]);
                *(LAS u32x2*)(lds + GC_ST + (16 * et + qi) * KST + 2 * (16 * w + 4 * gq)) = st; }
            if (c + 1 < 64) GC_STORE(((k + 1) & 1) * GC_BUF, (k + 1) & 3);
            __syncthreads();
        }
    }
    float* so = state_out + ((size_t)(b * 4 + h) * 128) * 256 + sl * 64;
#pragma unroll
    for (int et = 0; et < 4; ++et)
#pragma unroll
        for (int jj = 0; jj < 4; ++jj) so[(size_t)(16 * w + 4 * gq + jj) * 256 + 16 * et + qi] = accS[et][jj];
    __syncthreads();
}

__device__ __forceinline__ void gla_sample_item(LAS unsigned char* lds, const bf16_t* U, const float* GLR, const float* w_lr, const float* b_lr, const float* state_in, bf16_t* OA, float* state_out, int item) {
    const int tid = opaque_tid(), lane = tid & 63, w = __builtin_amdgcn_readfirstlane(tid >> 6);
    const int h = item & 3, b = item >> 2;
    LAS float* LA = (LAS float*)lds;
    LAS float* QT = LA + 1024;
    LAS float* KT = QT + 1024;
    LAS float* KD = KT + 1024;
    LAS float* QF = KD + 1024;
    LAS float* EB = QF + 1024;
    LAS float* ATT = EB + 128;
    LAS float* VF = ATT + 64;
    LAS float* OP = VF + 2048;
    const size_t mrow = (size_t)MP + b * 8;
    const int d0 = 2 * lane;
    float q0, q1, k0, k1;
    {
        const size_t m = mrow + w;
        const bf16_t* p = U + m * NU + h * 128 + d0;
        const unsigned qv = *(const unsigned*)(p + UQ), kv = *(const unsigned*)(p + UK);
        q0 = bflo(qv); q1 = bfhi(qv); k0 = bflo(kv); k1 = bfhi(kv);
        float z0 = b_lr[h * 128 + d0], z1 = b_lr[h * 128 + d0 + 1];
#pragma unroll
        for (int r = 0; r < 16; ++r) { const float gr = GLR[m * 16 + r]; z0 += gr * w_lr[r * 512 + h * 128 + d0]; z1 += gr * w_lr[r * 512 + h * 128 + d0 + 1]; }
        LA[w * 128 + d0] = logsigmoidf_(z0) * (1.f / 16.f); LA[w * 128 + d0 + 1] = logsigmoidf_(z1) * (1.f / 16.f);
        const u32x2 vv = *(const u32x2*)(U + m * NU + UV + h * 256 + 4 * lane);
        *(LAS f32x4*)(VF + w * 256 + 4 * lane) = (f32x4){bflo(vv.x), bfhi(vv.x), bflo(vv.y), bfhi(vv.y)};
    }
    __syncthreads();
    {
        float b0 = 0.f, b1 = 0.f, t0 = 0.f, t1 = 0.f;
#pragma unroll
        for (int j = 0; j < 8; ++j) { const float a0 = LA[j * 128 + d0], a1 = LA[j * 128 + d0 + 1]; if (j <= w) { b0 += a0; b1 += a1; } t0 += a0; t1 += a1; }
        const float qa = q0 * __expf(b0) * QSCALE, qb = q1 * __expf(b1) * QSCALE;
        QF[w * 128 + d0] = qa; QF[w * 128 + d0 + 1] = qb; QT[d0 * 8 + w] = qa; QT[(d0 + 1) * 8 + w] = qb;
        KD[w * 128 + d0] = k0 * __expf(-b0); KD[w * 128 + d0 + 1] = k1 * __expf(-b1);
        KT[d0 * 8 + w] = k0 * __expf(t0 - b0); KT[(d0 + 1) * 8 + w] = k1 * __expf(t1 - b1);
        if (w == 0) { EB[d0] = __expf(t0); EB[d0 + 1] = __expf(t1); }
    }
    __syncthreads();
    {
        const int j = lane & 7, part = lane >> 3; float s = 0.f;
#pragma unroll
        for (int d = 0; d < 16; ++d) s += QF[w * 128 + part * 16 + d] * KD[j * 128 + part * 16 + d];
        s += __shfl_xor(s, 8); s += __shfl_xor(s, 16); s += __shfl_xor(s, 32);
        if (lane < 8) ATT[w * 8 + j] = (j <= w) ? s : 0.f;
    }
    __syncthreads();
    {
        const int e = tid & 255, dh = tid >> 8;
        float vj[8], ao[8];
#pragma unroll
        for (int j = 0; j < 8; ++j) { vj[j] = VF[j * 256 + e]; ao[j] = 0.f; }
        const float* sin_ = state_in + ((size_t)(b * 4 + h) * 128 + 64 * dh) * 256 + e;
        float* sout = state_out + ((size_t)(b * 4 + h) * 128 + 64 * dh) * 256 + e;
        float s0v[64];
#pragma unroll
        for (int d = 0; d < 64; ++d) s0v[d] = sin_[(size_t)d * 256];
#pragma unroll
        for (int d = 0; d < 64; ++d) {
            const float s0 = s0v[d];
            const int dd = 64 * dh + d;
            const f32x4 ka = *(const LAS f32x4*)(KT + dd * 8), kb = *(const LAS f32x4*)(KT + dd * 8 + 4);
            const f32x4 qa = *(const LAS f32x4*)(QT + dd * 8), qb = *(const LAS f32x4*)(QT + dd * 8 + 4);
            float sn = EB[dd] * s0;
            sn += ka.x * vj[0] + ka.y * vj[1] + ka.z * vj[2] + ka.w * vj[3] + kb.x * vj[4] + kb.y * vj[5] + kb.z * vj[6] + kb.w * vj[7];
            sout[(size_t)d * 256] = sn;
            ao[0] += qa.x * s0; ao[1] += qa.y * s0; ao[2] += qa.z * s0; ao[3] += qa.w * s0; ao[4] += qb.x * s0; ao[5] += qb.y * s0; ao[6] += qb.z * s0; ao[7] += qb.w * s0;
        }
        if (dh == 1) {
#pragma unroll
            for (int i = 0; i < 8; ++i) OP[i * 256 + e] = ao[i];
        }
        __syncthreads();
        if (dh == 0) {
#pragma unroll
            for (int i = 0; i < 8; ++i) {
                float o = ao[i] + OP[i * 256 + e];
#pragma unroll
                for (int j = 0; j < 8; ++j) o += ATT[i * 8 + j] * vj[j];
                OA[(mrow + i) * 1024 + h * 256 + e] = (bf16_t)(cvt_pk_bf16(o, 0.f) & 0xffffu);
            }
        }
    }
    __syncthreads();
}

__device__ __forceinline__ void sa_load8(float (&x)[8], const bf16_t* U, const float* cb, size_t urow, int ucol, int Lb, int idx, int kv) {
    if (idx >= Lb) { const u32x4 t = *(const u32x4*)(U + (urow + (idx - Lb)) * NU + ucol);
        x[0] = bflo(t.x); x[1] = bfhi(t.x); x[2] = bflo(t.y); x[3] = bfhi(t.y); x[4] = bflo(t.z); x[5] = bfhi(t.z); x[6] = bflo(t.w); x[7] = bfhi(t.w); }
    else { const float* p = cb + ((size_t)idx * 2 + kv) * 512; const f32x4 a = *(const f32x4*)p, c = *(const f32x4*)(p + 4);
        x[0] = a.x; x[1] = a.y; x[2] = a.z; x[3] = a.w; x[4] = c.x; x[5] = c.y; x[6] = c.z; x[7] = c.w; }
}
__device__ __forceinline__ void attn_sample_item(LAS unsigned char* lds, const bf16_t* U, const float* cache, int g, int b, int t, bf16_t* OG, float* LSE) {
    const int tid = opaque_tid(), lane = tid & 63, w = __builtin_amdgcn_readfirstlane(tid >> 6), hh = lane >> 4, l16 = lane & 15;
    const int Lb = (g == 0) ? 128 : (g == 1 ? 512 : 2048), dil = 1 << (2 * g);
    LAS float* SCW = (LAS float*)lds + (w * 4 + hh) * 32;
    LAS float* OW = (LAS float*)lds + 1024;
    LAS float* MW = OW + 4096;
    LAS float* LW = MW + 32;
    const size_t mrow = (size_t)MP + b * 8;
    const int cq = UDQ + g * 512 + hh * 128 + 8 * l16, ck = UDK + g * 512 + hh * 128 + 8 * l16, cv = UDV + g * 512 + hh * 128 + 8 * l16;
    const float* cb = cache + (size_t)b * Lb * 1024 + hh * 128 + 8 * l16;
    float q[8];
    { const u32x4 qv = *(const u32x4*)(U + (mrow + t) * NU + cq);
      q[0] = bflo(qv.x); q[1] = bfhi(qv.x); q[2] = bflo(qv.y); q[3] = bfhi(qv.y); q[4] = bflo(qv.z); q[5] = bfhi(qv.z); q[6] = bflo(qv.w); q[7] = bfhi(qv.w); }
    const int nj = (w == 0) ? 17 : 16;
    {
        float x[8]; sa_load8(x, U, cb, mrow, ck, Lb, Lb + t - dil * w, 0);
        float s2 = 0.f;
#pragma unroll
        for (int e = 0; e < 8; ++e) s2 += q[e] * x[e];
        s2 += __shfl_xor(s2, 1); s2 += __shfl_xor(s2, 2); s2 += __shfl_xor(s2, 4); s2 += __shfl_xor(s2, 8);
        if (l16 == 0) SCW[0] = s2 * QSCALE;
    }
#pragma unroll 16
    for (int j = 1; j < 17; ++j) {
        const int m = w + 8 * j, mm = m > 128 ? 128 : m, idx = Lb + t - dil * mm;
        const float* p = cb + (size_t)idx * 1024; const f32x4 a = *(const f32x4*)p, c = *(const f32x4*)(p + 4);
        float s2 = (q[0] * a.x + q[1] * a.y) + (q[2] * a.z + q[3] * a.w) + (q[4] * c.x + q[5] * c.y) + (q[6] * c.z + q[7] * c.w);
        s2 += __shfl_xor(s2, 1); s2 += __shfl_xor(s2, 2); s2 += __shfl_xor(s2, 4); s2 += __shfl_xor(s2, 8);
        if (l16 == 0) SCW[j] = s2 * QSCALE;
    }
    __builtin_amdgcn_fence(__ATOMIC_RELEASE, "workgroup"); asm volatile("s_waitcnt lgkmcnt(0)" ::: "memory");
    float mx = -INFINITY;
    for (int j = 0; j < nj; ++j) mx = fmaxf(mx, SCW[j]);
    float l = 0.f, o[8];
#pragma unroll
    for (int e = 0; e < 8; ++e) o[e] = 0.f;
    {
        float x[8]; sa_load8(x, U, cb, mrow, cv, Lb, Lb + t - dil * w, 1);
        const float p = __expf(SCW[0] - mx); l += p;
#pragma unroll
        for (int e = 0; e < 8; ++e) o[e] += p * x[e];
    }
#pragma unroll 16
    for (int j = 1; j < 17; ++j) {
        const int m = w + 8 * j, mm = m > 128 ? 128 : m, idx = Lb + t - dil * mm;
        const float* p4 = cb + (size_t)idx * 1024 + 512; const f32x4 a = *(const f32x4*)p4, c = *(const f32x4*)(p4 + 4);
        const float p = (m <= 128) ? __expf(SCW[j] - mx) : 0.f; l += p;
        o[0] += p * a.x; o[1] += p * a.y; o[2] += p * a.z; o[3] += p * a.w; o[4] += p * c.x; o[5] += p * c.y; o[6] += p * c.z; o[7] += p * c.w;
    }
    {
        LAS float* op = OW + (w * 4 + hh) * 128 + 8 * l16;
        *(LAS f32x4*)op = (f32x4){o[0], o[1], o[2], o[3]}; *(LAS f32x4*)(op + 4) = (f32x4){o[4], o[5], o[6], o[7]};
        if (l16 == 0) { MW[w * 4 + hh] = mx; LW[w * 4 + hh] = l; }
    }
    __syncthreads();
    {
        const int h2 = tid >> 7, d = tid & 127;
        float Mx = -INFINITY;
#pragma unroll
        for (int ww = 0; ww < 8; ++ww) Mx = fmaxf(Mx, MW[ww * 4 + h2]);
        float L = 0.f, acc = 0.f;
#pragma unroll
        for (int ww = 0; ww < 8; ++ww) { const float f = __expf(MW[ww * 4 + h2] - Mx); L += LW[ww * 4 + h2] * f; acc += OW[(ww * 4 + h2) * 128 + d] * f; }
        OG[((size_t)g * M + mrow + t) * 512 + h2 * 128 + d] = (bf16_t)(cvt_pk_bf16(acc / L, 0.f) & 0xffffu);
        if (d == 0) LSE[((size_t)g * M + mrow + t) * 4 + h2] = Mx + __logf(L);
    }
    __syncthreads();
}

constexpr int KV_ROWS_P = 8 * (128 + 512 + 2048), KV_ROWS = KV_ROWS_P + 3 * 32 * 8, KV_ITEMS = (KV_ROWS + 63) / 64;
__device__ __forceinline__ void kvcopy_item(const bf16_t* __restrict__ U, float* __restrict__ out, int item) {
    const int tid = opaque_tid(), lane = tid & 63, w = tid >> 6;
    u32x4 v[8][2]; float* dstp[8];
#pragma unroll
    for (int rr = 0; rr < 8; ++rr) {
        int R = item * 64 + w * 8 + rr; if (R >= KV_ROWS) R = KV_ROWS - 1;
        int g; size_t m; float* dst;
        if (R < KV_ROWS_P) {
            int win;
            if (R < 8 * 128) { g = 0; win = 128; dst = out + O_KVP0; } else if (R < 8 * 640) { g = 1; win = 512; R -= 8 * 128; dst = out + O_KVP1; } else { g = 2; win = 2048; R -= 8 * 640; dst = out + O_KVP2; }
            const int b = R / win, i = R % win; m = (size_t)b * SEQ + SEQ - win + i; dst += (size_t)R * 1024;
        } else {
            R -= KV_ROWS_P; g = R / 256; R -= g * 256; const int b = R >> 3, t = R & 7; const int Lb = (g == 0) ? 128 : (g == 1 ? 512 : 2048);
            m = (size_t)MP + b * 8 + t; dst = out + (g == 0 ? O_KVS0 : (g == 1 ? O_KVS1 : O_KVS2)) + ((size_t)b * Lb + Lb - 8 + t) * 1024;
        }
        const bf16_t* src = U + m * NU + g * 512;
        v[rr][0] = *(const u32x4*)(src + UDK + 8 * lane); v[rr][1] = *(const u32x4*)(src + UDV + 8 * lane);
        dstp[rr] = dst;
    }
#pragma unroll
    for (int rr = 0; rr < 8; ++rr)
#pragma unroll
        for (int s2 = 0; s2 < 2; ++s2) {
            const u32x4 x = v[rr][s2];
            float* d = dstp[rr] + s2 * 512 + 8 * lane;
            *(f32x4*)d = (f32x4){bflo(x.x), bfhi(x.x), bflo(x.y), bfhi(x.y)}; *(f32x4*)(d + 4) = (f32x4){bflo(x.z), bfhi(x.z), bflo(x.w), bfhi(x.w)};
        }
}

constexpr int QA_PRE = 2048 / PRE_CH, QA_SATT = 768, QA_SGLA = 128;
constexpr int KV_ITEMS_P = KV_ROWS_P / 64;
static_assert(KV_ROWS_P % 64 == 0, "prompt kv rows fill whole items");
constexpr int QA0 = QA_PRE, QA1 = QA0 + QA_SATT, QA2 = QA1 + QA_SGLA, QA_TOTAL = QA2 + (KV_ITEMS - KV_ITEMS_P);
constexpr int QB_CHAIN = 128, QB_ATT = ATT_ITEMS, QB_TOTAL = QB_CHAIN + QB_ATT;

__device__ __forceinline__ void p2_queue(const Args& a, LAS unsigned char* lds, int which, int cslot, int qlo, int qhi) {
    unsigned char* ws = a.ws;
    const bf16_t* U = (const bf16_t*)(ws + WS_U); const float* GLR = (const float*)(ws + WS_GLR);
    bf16_t* OA = (bf16_t*)(ws + WS_OA); bf16_t* OG = (bf16_t*)(ws + WS_OG); float* LSE = (float*)(ws + WS_LSE);
    bf16_t* QIN = (bf16_t*)(ws + WS_XN); bf16_t* KEND = QIN + (size_t)MP * 512; float* DEC = (float*)(ws + WS_AB);
    unsigned* ctr = (unsigned*)(ws + WS_CTL) + 64 * cslot;
    LAS int* slot = (LAS int*)(lds + LDS_BYTES - 16);
    const int total0 = which ? QB_TOTAL : QA_TOTAL; const int total = qhi < total0 ? qhi : total0;
    for (;;) {
        if (threadIdx.x == 0) *slot = qlo + (int)atomicAdd(ctr, 1u);
        __syncthreads();
        const int it = *slot;
        __syncthreads();
        if (it >= total) break;
        if (which == 0) {
            if (it < QA_SATT) { const int r = it, t = r & 7, g = 2 - ((r >> 3) % 3), b = r / 24; attn_sample_item(lds, U, a.in[3 + g], g, b, t, OG, LSE); }
            else if (it < QA_SATT + QA_SGLA) gla_sample_item(lds, U, GLR, a.in[11], a.in[12], a.in[2], OA, a.out + O_SGS, it - QA_SATT);
            else if (it < QA2) gla_pre_item(lds, U, GLR, a.in[11], a.in[12], QIN, KEND, DEC, OA, it - QA_SATT - QA_SGLA);
            else kvcopy_item(U, a.out, KV_ITEMS_P + it - QA2);
        } else {
            if (it < QB_CHAIN) gla_chain_item(lds, U, QIN, KEND, DEC, OA, a.out + O_SGP, it);
            else attn_prompt_item(lds, U, OG, LSE, it - QB_CHAIN);
        }
    }
}

struct CmbRow { u32x2 oa[4], gg[4], og[3][2], dg[2]; float lse[3][2]; };
__device__ __forceinline__ void cmb_load(CmbRow& r, const bf16_t* __restrict__ U, const bf16_t* __restrict__ OA, const bf16_t* __restrict__ OG, const float* __restrict__ LSE, int m, int lane) {
    const bf16_t* ur = U + (size_t)m * NU;
#pragma unroll
    for (int j = 0; j < 4; ++j) { r.oa[j] = __builtin_nontemporal_load((const u32x2*)(OA + (size_t)m * 1024 + 4 * lane + 256 * j)); r.gg[j] = __builtin_nontemporal_load((const u32x2*)(ur + UG + 4 * lane + 256 * j)); }
#pragma unroll
    for (int j = 0; j < 2; ++j) {
        const int c = 4 * lane + 256 * j, h = c >> 7;
        r.dg[j] = __builtin_nontemporal_load((const u32x2*)(ur + UDG + c));
#pragma unroll
        for (int g = 0; g < 3; ++g) { r.og[g][j] = __builtin_nontemporal_load((const u32x2*)(OG + ((size_t)g * M + m) * 512 + c)); r.lse[g][j] = LSE[((size_t)g * M + m) * 4 + h]; }
    }
}
__device__ __forceinline__ void cmb_compute(const CmbRow& r, const f32x4 (&gv)[4], bf16_t* __restrict__ AB, int m, int lane) {
#pragma unroll
    for (int j = 0; j < 4; ++j) {
        f32x4 o = {bflo(r.oa[j].x), bfhi(r.oa[j].x), bflo(r.oa[j].y), bfhi(r.oa[j].y)};
        const float ss = wave_sum((o.x * o.x + o.y * o.y) + (o.z * o.z + o.w * o.w));
        const float rs = rsqrtf(ss * (1.f / 256.f) + NORM_EPS);
        o = o * rs * gv[j];
        o.x *= siluf_(bflo(r.gg[j].x)); o.y *= siluf_(bfhi(r.gg[j].x)); o.z *= siluf_(bflo(r.gg[j].y)); o.w *= siluf_(bfhi(r.gg[j].y));
        u32x2 st; st.x = cvt_pk_bf16(o.x, o.y); st.y = cvt_pk_bf16(o.z, o.w);
        *(u32x2*)(AB + (size_t)m * 1536 + 4 * lane + 256 * j) = st;
    }
#pragma unroll
    for (int j = 0; j < 2; ++j) {
        const int c = 4 * lane + 256 * j;
        const float l0 = r.lse[0][j], l1 = r.lse[1][j], l2 = r.lse[2][j];
        const float mx = fmaxf(l0, fmaxf(l1, l2));
        float w0 = __expf(l0 - mx), w1 = __expf(l1 - mx), w2 = __expf(l2 - mx); const float inv = 1.0f / (w0 + w1 + w2); w0 *= inv; w1 *= inv; w2 *= inv;
        const u32x2 a0 = r.og[0][j], a1 = r.og[1][j], a2 = r.og[2][j];
        f32x4 o;
        o.x = w0 * bflo(a0.x) + w1 * bflo(a1.x) + w2 * bflo(a2.x); o.y = w0 * bfhi(a0.x) + w1 * bfhi(a1.x) + w2 * bfhi(a2.x);
        o.z = w0 * bflo(a0.y) + w1 * bflo(a1.y) + w2 * bflo(a2.y); o.w = w0 * bfhi(a0.y) + w1 * bfhi(a1.y) + w2 * bfhi(a2.y);
        const u32x2 dg = r.dg[j];
        o.x *= siluf_(bflo(dg.x)); o.y *= siluf_(bfhi(dg.x)); o.z *= siluf_(bflo(dg.y)); o.w *= siluf_(bfhi(dg.y));
        u32x2 st; st.x = cvt_pk_bf16(o.x, o.y); st.y = cvt_pk_bf16(o.z, o.w);
        *(u32x2*)(AB + (size_t)m * 1536 + 1024 + c) = st;
    }
}
__device__ __forceinline__ void p2b_combine(const Args& a) {
    const int tid = threadIdx.x, lane = tid & 63, wave = tid >> 6;
    const int gw = blockIdx.x * 8 + wave, NGW = gridDim.x * 8;
    unsigned char* ws = a.ws;
    const bf16_t* U = (const bf16_t*)(ws + WS_U); const bf16_t* OA = (const bf16_t*)(ws + WS_OA); const bf16_t* OG = (const bf16_t*)(ws + WS_OG); const float* LSE = (const float*)(ws + WS_LSE);
    bf16_t* AB = (bf16_t*)(ws + WS_AB);
    const float* gn = a.in[13];
    f32x4 gv[4];
#pragma unroll
    for (int j = 0; j < 4; ++j) gv[j] = *(const f32x4*)(gn + 4 * lane + 256 * j);
    CmbRow r0, r1, r2, r3;
    int m = gw;
    const int N1 = NGW;
    if (m < M) cmb_load(r0, U, OA, OG, LSE, m, lane);
    if (m + N1 < M) cmb_load(r1, U, OA, OG, LSE, m + N1, lane);
    if (m + 2 * N1 < M) cmb_load(r2, U, OA, OG, LSE, m + 2 * N1, lane);
    for (; m < M; m += 4 * N1) {
        if (m + 3 * N1 < M) cmb_load(r3, U, OA, OG, LSE, m + 3 * N1, lane);
        cmb_compute(r0, gv, AB, m, lane);
        if (m + 4 * N1 < M) cmb_load(r0, U, OA, OG, LSE, m + 4 * N1, lane);
        if (m + N1 < M) cmb_compute(r1, gv, AB, m + N1, lane);
        if (m + 5 * N1 < M) cmb_load(r1, U, OA, OG, LSE, m + 5 * N1, lane);
        if (m + 2 * N1 < M) cmb_compute(r2, gv, AB, m + 2 * N1, lane);
        if (m + 6 * N1 < M) cmb_load(r2, U, OA, OG, LSE, m + 6 * N1, lane);
        if (m + 3 * N1 < M) cmb_compute(r3, gv, AB, m + 3 * N1, lane);
    }
}

struct PostRow { u32x2 t[4]; f32x4 x[4]; };
__device__ __forceinline__ void post_load(PostRow& r, const Args& a, const bf16_t* __restrict__ T, int m, int lane) {
    const float* __restrict__ xr = (m < MP) ? a.in[0] + (size_t)m * DM : a.in[1] + (size_t)(m - MP) * DM;
#pragma unroll
    for (int j = 0; j < 4; ++j) { r.t[j] = *(const u32x2*)(T + (size_t)m * 1024 + 4 * lane + 256 * j); r.x[j] = __builtin_nontemporal_load((const f32x4*)(xr + 4 * lane + 256 * j)); }
}
__device__ __forceinline__ void post_compute(const PostRow& r, const f32x4 (&gv)[4], bf16_t* __restrict__ HB, int m, int lane) {
    f32x4 t[4]; float ss = 0.f;
#pragma unroll
    for (int j = 0; j < 4; ++j) { const u32x2 tv = r.t[j]; t[j] = (f32x4){bflo(tv.x), bfhi(tv.x), bflo(tv.y), bfhi(tv.y)};
        ss += (t[j].x * t[j].x + t[j].y * t[j].y) + (t[j].z * t[j].z + t[j].w * t[j].w); }
    const float rs = rsqrtf(wave_sum(ss) * (1.f / DM) + NORM_EPS);
#pragma unroll
    for (int j = 0; j < 4; ++j) {
        const f32x4 hh = r.x[j] + t[j] * rs * gv[j];
        u32x2 st; st.x = cvt_pk_bf16(hh.x, hh.y); st.y = cvt_pk_bf16(hh.z, hh.w);
        *(u32x2*)(HB + (size_t)m * 1024 + 4 * lane + 256 * j) = st;
    }
}
__device__ __forceinline__ void p5_post(const Args& a) {
    const int tid = threadIdx.x, lane = tid & 63, wave = tid >> 6;
    const int gw = blockIdx.x * 8 + wave, N1 = gridDim.x * 8;
    unsigned char* ws = a.ws;
    const bf16_t* T = (const bf16_t*)(ws + WS_OA); bf16_t* HB = (bf16_t*)(ws + WS_AB);
    const float* gpost = a.in[9];
    f32x4 gv[4];
#pragma unroll
    for (int j = 0; j < 4; ++j) gv[j] = *(const f32x4*)(gpost + 4 * lane + 256 * j);
    PostRow r0, r1, r2, r3;
    int m = gw;
    if (m < M) post_load(r0, a, T, m, lane);
    if (m + N1 < M) post_load(r1, a, T, m + N1, lane);
    if (m + 2 * N1 < M) post_load(r2, a, T, m + 2 * N1, lane);
    for (; m < M; m += 4 * N1) {
        if (m + 3 * N1 < M) post_load(r3, a, T, m + 3 * N1, lane);
        post_compute(r0, gv, HB, m, lane);
        if (m + 4 * N1 < M) post_load(r0, a, T, m + 4 * N1, lane);
        if (m + N1 < M) post_compute(r1, gv, HB, m + N1, lane);
        if (m + 5 * N1 < M) post_load(r1, a, T, m + 5 * N1, lane);
        if (m + 2 * N1 < M) post_compute(r2, gv, HB, m + 2 * N1, lane);
        if (m + 6 * N1 < M) post_load(r2, a, T, m + 6 * N1, lane);
        if (m + 3 * N1 < M) post_compute(r3, gv, HB, m + 3 * N1, lane);
    }
}

constexpr int N_PHASES = 9;
__global__ void __launch_bounds__(512, 2) fwd_kernel(Args args) {
    extern __shared__ __attribute__((aligned(16))) unsigned char lds_raw[];
    LAS unsigned char* lds = (LAS unsigned char*)lds_raw;
    const int lo = args.ph_lo, hi = args.ph_hi;
    unsigned char* ws = args.ws;
    const int G = gridDim.x, bx = blockIdx.x;
#if MK_SINGLE
    cg::grid_group grid = cg::this_grid();
    if (threadIdx.x < 4) ((LAS unsigned*)(lds + LDS_BYTES - 32))[threadIdx.x] = 0u;
    __syncthreads();
    const XcdBarrier xbar = xcd_barrier_post((unsigned*)(ws + WS_CTL) + CW_BAR, (volatile LAS unsigned*)(lds + LDS_BYTES - 32));
    if (hi > 1000) grid.sync();
#define SEAM(k) do { if (lo <= (k) && (k) + 1 < hi) xcd_barrier(xbar); } while (0)
#define REPS(k) (((k) == PROBE_DUP) ? 2 : 1)
#define REPSEAM(rep, k) do { if ((rep) + 1 < REPS(k)) xcd_barrier(xbar); } while (0)
#else
#define SEAM(k) do { } while (0)
#define REPS(k) 1
#define REPSEAM(rep, k) do { } while (0)
#endif
#define IN(k) (lo <= (k) && (k) < hi)
    if (IN(0)) { for (int rep = 0; rep < REPS(0); ++rep) { p0_prologue(args, lds); REPSEAM(rep, 0); } SEAM(0); }
    if (IN(1)) {
        pg8::Gemm g{(const bf16_t*)(ws + WS_XN), (const bf16_t*)(ws + WS_WIN), 1024, 1024, 1024};
        pg8::StaticOrder S; S.init(M / 256, NU / 256, G, bx);
        pg8::Epi<4> E{(bf16_t*)(ws + WS_U), NU, nullptr, 0, args.out};
        for (int rep = 0; rep < REPS(1); ++rep) { pg8::gemm_phase(lds, g, S, E); REPSEAM(rep, 1); }
        if (G == 256 && bx >= 40) copy_g2_range(args, 0u, CP_S1, bx - 40, G - 40);
        SEAM(1);
    }
    if (IN(2) || IN(3)) {
        for (int pass = 0; pass < 3; ++pass) {
            int which, qlo = 0, qhi = 1 << 30, cslot;
            if (pass == 0) { if (PROBE_Q != 0 && PROBE_Q != 1) continue; which = PROBE_Q; qlo = PROBE_LO; qhi = PROBE_HI; cslot = 2; }
            else { which = pass - 1; cslot = which; if (!IN(2 + which)) continue; }
            p2_queue(args, lds, which, cslot, qlo, qhi);
#if MK_SINGLE
            if (pass < 2 || hi > 4) xcd_barrier(xbar);
#endif
        }
    }
    if (IN(4)) { for (int rep = 0; rep < REPS(4); ++rep) { p2b_combine(args); REPSEAM(rep, 4); } SEAM(4); }
    if (IN(5)) {
        pg8::StaticOrder S; S.init(M / 256, 4, G, bx);
        for (int rep = 0; rep < REPS(5); ++rep) {
        { pg8::Gemm g{(const bf16_t*)(ws + WS_AB), (const bf16_t*)(ws + WS_WAB), 1536, 1536, 1024};
          pg8::Epi<0> E{(bf16_t*)(ws + WS_XN), 1024, nullptr, 0, nullptr};
          pg8::gemm_phase(lds, g, S, E); }
        { pg8::Gemm g{(const bf16_t*)(ws + WS_AB) + 1024, (const bf16_t*)(ws + WS_WAB) + 1024, 1536, 1536, 512};
          pg8::Epi<5> E{(bf16_t*)(ws + WS_XN), 1024, (const bf16_t*)(ws + WS_U) + UGA, NU, nullptr};
          pg8::gemm_phase(lds, g, S, E); }
        REPSEAM(rep, 5); }
        if (G == 256 && bx >= 4) copy_g2_range(args, CP_S1, CP_S2, bx - 4, G - 4);
        SEAM(5);
    }
    if (IN(6)) {
        pg8::StaticOrder S; S.init(M / 256, 4, G, bx);
        if (PROBE_Q == 2) { pg8::Gemm g{(const bf16_t*)(ws + WS_XN), (const bf16_t*)(ws + WS_WO), 1024, 1024, 1024};
          pg8::Epi<0> E{(bf16_t*)(ws + WS_OA), 1024, nullptr, 0, nullptr};
          pg8::gemm_phase(lds, g, S, E); xcd_barrier(xbar); }
        for (int rep = 0; rep < REPS(6); ++rep) {
        { pg8::Gemm g{(const bf16_t*)(ws + WS_XN), (const bf16_t*)(ws + WS_WO), 1024, 1024, 1024};
          pg8::Epi<0> E{(bf16_t*)(ws + WS_OA), 1024, nullptr, 0, nullptr};
          pg8::gemm_phase(lds, g, S, E); }
        { pg8::Gemm g{(const bf16_t*)(ws + WS_PE), (const bf16_t*)(ws + WS_WP), 256, 256, 256};
          pg8::Epi<0> E{(bf16_t*)(ws + WS_OG), 1024, nullptr, 0, nullptr};
          pg8::gemm_phase(lds, g, S, E); }
        REPSEAM(rep, 6); }
        if (G == 256 && bx >= 4) copy_g2_range(args, CP_S2, CP_S3, bx - 4, G - 4);
        SEAM(6);
    }
    if (IN(7)) { for (int rep = 0; rep < REPS(7); ++rep) { p5_post(args); REPSEAM(rep, 7); } SEAM(7); }
    if (IN(8)) {
        pg8::StaticOrder S; S.init(M / 256, 4, G, bx);
        pg8::Gemm g{(const bf16_t*)(ws + WS_AB), (const bf16_t*)(ws + WS_WG), 1024, 1024, 1024};
        pg8::Epi<3> E{(bf16_t*)(ws + WS_OG), 1024, (const bf16_t*)(ws + WS_AB), 1024, args.out + O_Y};
        pg8::gemm_phase(lds, g, S, E);
        if (G == 256 && bx >= 4) copy_g2_range(args, CP_S3, CP_S4, bx - 4, G - 4);
    }
#undef IN
#undef SEAM
#undef REPS
#undef REPSEAM
}

extern "C" void kernel_launch(void* const* d_in, const int* in_sizes, int n_in, void* d_out, int out_size, void* d_ws, size_t ws_size, hipStream_t stream) {
    static int grid = 0;
    if (grid == 0) {
        int dev = 0, cus = 0, per_cu = 0;
        (void)hipGetDevice(&dev);
        (void)hipDeviceGetAttribute(&cus, hipDeviceAttributeMultiprocessorCount, dev);
        if (hipFuncSetAttribute((const void*)fwd_kernel, hipFuncAttributeMaxDynamicSharedMemorySize, LDS_BYTES) != hipSuccess) { fprintf(stderr, "kernel_launch: hipFuncSetAttribute failed\n"); grid = -1; return; }
        if (hipOccupancyMaxActiveBlocksPerMultiprocessor(&per_cu, (const void*)fwd_kernel, 512, LDS_BYTES) != hipSuccess || per_cu < 1) { fprintf(stderr, "kernel_launch: occupancy query gave %d\n", per_cu); per_cu = 1; }
        (void)hipGetLastError();
        grid = cus * 1;
        if (ws_size < WS_END) { fprintf(stderr, "kernel_launch: workspace too small (%zu < %zu)\n", ws_size, (size_t)WS_END); grid = -1; return; }
    }
    if (grid < 0) return;
    if (hipMemsetAsync((char*)d_ws + WS_CTL, 0, CTL_ZERO_BYTES, stream) != hipSuccess) { fprintf(stderr, "kernel_launch: memset failed\n"); return; }
    Args a{};
    for (int i = 0; i < 19; ++i) a.in[i] = (const float*)d_in[i];
    a.out = (float*)d_out; a.ws = (unsigned char*)d_ws;
#if MK_SINGLE
    a.ph_lo = 0; a.ph_hi = N_PHASES;
    void* kargs[] = {&a};
    hipError_t e = hipLaunchCooperativeKernel((const void*)fwd_kernel, dim3(grid), dim3(512), kargs, LDS_BYTES, stream);
    if (e != hipSuccess) fprintf(stderr, "cooperative launch failed: %s (grid %d)\n", hipGetErrorString(e), grid);
#else
    for (int p = 0; p < N_PHASES; ++p) {
        a.ph_lo = p; a.ph_hi = p + 1;
        hipLaunchKernelGGL(fwd_kernel, dim3(grid), dim3(512), LDS_BYTES, stream, a);
    }
#endif
}
```

```cpp
#include <hip/hip_runtime.h>
#include <hip/hip_cooperative_groups.h>
#include <cstdio>
#include <cstdint>
namespace cg = cooperative_groups;

#ifndef MK_SINGLE
#define MK_SINGLE 1
#endif

#define LAS __attribute__((address_space(3)))
typedef unsigned short bf16_t;
typedef short bf16x8 __attribute__((ext_vector_type(8)));
typedef short s16x4 __attribute__((ext_vector_type(4)));
typedef float f32x4 __attribute__((ext_vector_type(4)));
typedef float f32x2 __attribute__((ext_vector_type(2)));
typedef unsigned u32x4 __attribute__((ext_vector_type(4)));
typedef unsigned u32x2 __attribute__((ext_vector_type(2)));

constexpr int DM = 1024, NBATCH = 8, SEQ = 4096, MP = NBATCH * SEQ, DECB = 32, DECT = 8, MS = DECB * DECT, M = MP + MS;
constexpr int NU = 10240;
constexpr int UQ = 0, UK = 512, UV = 1024, UG = 2048, UDQ = 3072, UDK = 4608, UDV = 6144, UDG = 7680, UGA = 8192, UGB = 9216;
constexpr int WIN_W = 10256;
constexpr float NORM_EPS = 1e-6f;
constexpr float QSCALE = 0.08838834764831845f;

constexpr size_t al256(size_t x) { return (x + 255) & ~(size_t)255; }
constexpr size_t WS_CTL = 0;
constexpr size_t WS_XN = 1u << 20;
constexpr size_t WS_GLR = WS_XN + al256((size_t)M * 1024 * 2);
constexpr size_t WS_WIN = WS_GLR + al256((size_t)M * 16 * 4);
constexpr size_t WS_WAB = WS_WIN + al256((size_t)NU * 1024 * 2);
constexpr size_t WS_WO = WS_WAB + al256((size_t)1024 * 1536 * 2);
constexpr size_t WS_WG = WS_WO + al256((size_t)1024 * 1024 * 2);
constexpr size_t WS_WP = WS_WG + al256((size_t)1024 * 1024 * 2);
constexpr size_t WS_PE = WS_WP + al256((size_t)1024 * 256 * 2);
constexpr size_t WS_U = WS_PE + al256((size_t)M * 256 * 2);
constexpr size_t WS_OA = WS_U + al256((size_t)M * NU * 2);
constexpr size_t WS_OG = WS_OA + al256((size_t)M * 1024 * 2);
constexpr size_t WS_LSE = WS_OG + al256((size_t)3 * M * 512 * 2);
constexpr size_t WS_AB = WS_LSE + al256((size_t)3 * M * 4 * 4);
constexpr size_t WS_END = WS_AB + al256((size_t)M * 1536 * 2);
static_assert(WS_END <= (size_t)1073741824, "workspace map exceeds 4x largest tensor");

constexpr size_t O_Y = 0;
constexpr size_t O_SGP = (size_t)M * 1024;
constexpr size_t O_SGS = O_SGP + (size_t)8 * 4 * 128 * 256;
constexpr size_t O_KVP0 = O_SGS + (size_t)32 * 4 * 128 * 256;
constexpr size_t O_KVP1 = O_KVP0 + (size_t)8 * 128 * 1024;
constexpr size_t O_KVP2 = O_KVP1 + (size_t)8 * 512 * 1024;
constexpr size_t O_KVS0 = O_KVP2 + (size_t)8 * 2048 * 1024;
constexpr size_t O_KVS1 = O_KVS0 + (size_t)32 * 128 * 1024;
constexpr size_t O_KVS2 = O_KVS1 + (size_t)32 * 512 * 1024;

constexpr int LDS_BYTES = 147456;
constexpr int CW_BAR = 4096;
constexpr size_t CTL_ZERO_BYTES = 65536;
#ifndef PROBE_Q
#define PROBE_Q (-1)
#define PROBE_LO 0
#define PROBE_HI 0
#endif
#ifndef PROBE_DUP
#define PROBE_DUP (-1)
#endif

__device__ __forceinline__ unsigned cvt_pk_bf16_asm(float lo, float hi) { unsigned r; asm volatile("v_cvt_pk_bf16_f32 %0, %1, %2" : "=v"(r) : "v"(lo), "v"(hi)); return r; }
typedef __bf16 bf16x2_t __attribute__((ext_vector_type(2)));
__device__ __forceinline__ unsigned cvt_pk_bf16(float lo, float hi) { const f32x2 v = {lo, hi}; const bf16x2_t r = __builtin_convertvector(v, bf16x2_t); return __builtin_bit_cast(unsigned, r); }
__device__ __forceinline__ float bflo(unsigned u) { return __uint_as_float(u << 16); }
__device__ __forceinline__ float bfhi(unsigned u) { return __uint_as_float(u & 0xffff0000u); }
__device__ __forceinline__ float bf1(bf16_t u) { return __uint_as_float(((unsigned)u) << 16); }
__device__ __forceinline__ float sigmoidf_(float x) { return __builtin_amdgcn_rcpf(1.0f + __expf(-x)); }
__device__ __forceinline__ float siluf_(float x) { return x * sigmoidf_(x); }
template <int CTRL> __device__ __forceinline__ float dpp_f(float v) { return __builtin_bit_cast(float, __builtin_amdgcn_update_dpp(0, __builtin_bit_cast(int, v), CTRL, 0xF, 0xF, true)); }
__device__ __forceinline__ float row16_sum(float v) {
    v += dpp_f<0xB1>(v);
    v += dpp_f<0x4E>(v);
    v += dpp_f<0x141>(v);
    v += dpp_f<0x140>(v);
    return v;
}
__device__ __forceinline__ float wave_sum(float v) {
    v = row16_sum(v);
    v += __shfl_xor(v, 16); v += __shfl_xor(v, 32);
    return v;
}
__device__ __forceinline__ float wave_max(float v) {
#pragma unroll
    for (int o = 1; o < 64; o <<= 1) v = fmaxf(v, __shfl_xor(v, o));
    return v;
}
__device__ __forceinline__ float logsigmoidf_(float z) { return fminf(z, 0.f) - __logf(1.0f + __expf(-fabsf(z))); }
__device__ __forceinline__ int opaque_tid() { int t = threadIdx.x; asm volatile("" : "+v"(t)); return t; }
#define MFMA16(a, b, c) __builtin_amdgcn_mfma_f32_16x16x32_bf16((a), (b), (c), 0, 0, 0)
__device__ __forceinline__ s16x4 tr_read(LAS unsigned char* p) { return __builtin_amdgcn_ds_read_tr16_b64_v4i16((LAS s16x4*)p); }
__device__ __forceinline__ bf16x8 cat4(s16x4 lo, s16x4 hi) { return __builtin_shufflevector(lo, hi, 0, 1, 2, 3, 4, 5, 6, 7); }

namespace pg8 {
constexpr int BM = 256, BK = 64, HALF = 128, HTB = HALF * BK * 2, STAGE_BYTES = 8 * HTB, NXCD = 8, WGM = 8;
__host__ __device__ __forceinline__ int lds_byte(int r, int c) { const int st = (r >> 4) * 2 + (c >> 5), rr = r & 15, cc = c & 31, ob = rr * 64 + cc * 2; return st * 1024 + (ob ^ (((ob >> 9) & 1) << 5)); }
__host__ __device__ __forceinline__ void stage_rc(int b, int& R, int& C) { const int st = b / 1024, sb = b % 1024, swz = sb ^ (((sb >> 9) & 1) << 5); R = (st >> 1) * 16 + swz / 64; C = (st & 1) * 32 + (swz % 64) / 2; }
__host__ __device__ __forceinline__ int perm32(int rho) { const int n = rho >> 4, i = rho & 15; return 8 * (i >> 2) + 4 * n + (i & 3); }

struct Unit { int pm, pn; };
struct Gemm { const bf16_t* A; const bf16_t* Bt; int lda, ldb, K; };

struct StaticOrder {
    int nM, nN, nwg, G, c;
    __host__ __device__ void init(int nM_, int nN_, int G_, int c_) { nM = nM_; nN = nN_; nwg = nM * nN; G = G_; c = c_; }
    __host__ __device__ bool next(int i, Unit& u) const {
        const long L = (long)i * G + c; if (L >= nwg) return false;
        int wgid = (int)L; { const int q = nwg / NXCD, r = nwg % NXCD, xcd = wgid % NXCD, off = wgid / NXCD; wgid = (xcd < r ? xcd * (q + 1) : r * (q + 1) + (xcd - r) * q) + off; }
        const int nig = WGM * nN, gid = wgid / nig, fm = gid * WGM, gsz = (nM - fm) < WGM ? (nM - fm) : WGM;
        u.pm = fm + ((wgid % nig) % gsz); u.pn = (wgid % nig) / gsz; return true;
    }
};

template <int MODE> struct Epi {
    static constexpr bool PERM = true;
    bf16_t* O; int ldc; const bf16_t* G; int ldg; float* F;
    __device__ __forceinline__ void operator()(const f32x4 (&acc)[2][2][4][2], const Unit& u, int wr, int wc, int fr, int fq) const {
        const int row0 = u.pm * BM + wr * 64 + fr; const int col0 = u.pn * BM + wc * 32 + 8 * fq;
#pragma unroll
        for (int ai = 0; ai < 2; ++ai)
#pragma unroll
            for (int m = 0; m < 4; ++m) {
                const size_t row = (size_t)(row0 + ai * HALF + m * 16);
#pragma unroll
                for (int bj = 0; bj < 2; ++bj) {
                    const int col = col0 + bj * HALF;
                    f32x4 v0 = acc[ai][bj][m][0], v1 = acc[ai][bj][m][1];
                    if (MODE == 1 || MODE == 2) {
                        const u32x4 g = *(const u32x4*)(G + row * ldg + col);
                        v0[0] *= sigmoidf_(bflo(g.x)); v0[1] *= sigmoidf_(bfhi(g.x)); v0[2] *= sigmoidf_(bflo(g.y)); v0[3] *= sigmoidf_(bfhi(g.y));
                        v1[0] *= sigmoidf_(bflo(g.z)); v1[1] *= sigmoidf_(bfhi(g.z)); v1[2] *= sigmoidf_(bflo(g.w)); v1[3] *= sigmoidf_(bfhi(g.w));
                    }
                    if (MODE == 5) {
                        const u32x4 ga = __builtin_nontemporal_load((const u32x4*)(G + row * ldg + col)), gb = __builtin_nontemporal_load((const u32x4*)(G + row * ldg + col + (UGB - UGA)));
                        const u32x4 o = *(const u32x4*)(O + row * ldc + col);
                        v0[0] = bflo(o.x) * sigmoidf_(bflo(ga.x)) + v0[0] * sigmoidf_(bflo(gb.x)); v0[1] = bfhi(o.x) * sigmoidf_(bfhi(ga.x)) + v0[1] * sigmoidf_(bfhi(gb.x));
                        v0[2] = bflo(o.y) * sigmoidf_(bflo(ga.y)) + v0[2] * sigmoidf_(bflo(gb.y)); v0[3] = bfhi(o.y) * sigmoidf_(bfhi(ga.y)) + v0[3] * sigmoidf_(bfhi(gb.y));
                        v1[0] = bflo(o.z) * sigmoidf_(bflo(ga.z)) + v1[0] * sigmoidf_(bflo(gb.z)); v1[1] = bfhi(o.z) * sigmoidf_(bfhi(ga.z)) + v1[1] * sigmoidf_(bfhi(gb.z));
                        v1[2] = bflo(o.w) * sigmoidf_(bflo(ga.w)) + v1[2] * sigmoidf_(bflo(gb.w)); v1[3] = bfhi(o.w) * sigmoidf_(bfhi(ga.w)) + v1[3] * sigmoidf_(bfhi(gb.w));
                    }
                    if (MODE == 2) {
                        const u32x4 o = *(const u32x4*)(O + row * ldc + col);
                        v0[0] += bflo(o.x); v0[1] += bfhi(o.x); v0[2] += bflo(o.y); v0[3] += bfhi(o.y);
                        v1[0] += bflo(o.z); v1[1] += bfhi(o.z); v1[2] += bflo(o.w); v1[3] += bfhi(o.w);
                    }
                    if (MODE == 3) {
                        const u32x4 p = *(const u32x4*)(O + row * ldc + col);
                        float* fp = F + row * ldc + col;
                        const u32x4 hb = *(const u32x4*)(G + row * ldg + col);
                        f32x4 h0 = {bflo(hb.x), bfhi(hb.x), bflo(hb.y), bfhi(hb.y)}, h1 = {bflo(hb.z), bfhi(hb.z), bflo(hb.w), bfhi(hb.w)};
                        h0[0] += bflo(p.x) * sigmoidf_(v0[0]); h0[1] += bfhi(p.x) * sigmoidf_(v0[1]); h0[2] += bflo(p.y) * sigmoidf_(v0[2]); h0[3] += bfhi(p.y) * sigmoidf_(v0[3]);
                        h1[0] += bflo(p.z) * sigmoidf_(v1[0]); h1[1] += bfhi(p.z) * sigmoidf_(v1[1]); h1[2] += bflo(p.w) * sigmoidf_(v1[2]); h1[3] += bfhi(p.w) * sigmoidf_(v1[3]);
                        *(f32x4*)fp = h0; *(f32x4*)(fp + 4) = h1;
                    } else {
                        u32x4 w; w.x = cvt_pk_bf16_asm(v0[0], v0[1]); w.y = cvt_pk_bf16_asm(v0[2], v0[3]); w.z = cvt_pk_bf16_asm(v1[0], v1[1]); w.w = cvt_pk_bf16_asm(v1[2], v1[3]);
                        if (MODE == 4) {
                            __builtin_nontemporal_store(w, (u32x4*)(O + row * ldc + col));
                            if (u.pn >= UDK / 256 && u.pn < (UDV + 1536) / 256 && u.pm < MP / 256) {
                                const int cc = col - UDK, s2 = cc >= 1536 ? 1 : 0, r = cc - s2 * 1536, gk = r >> 9, hd = r & 511;
                                const int win = 128 << (2 * gk), bb = (int)(row >> 12), i = (int)(row & 4095) - (4096 - win);
                                if (i >= 0) {
                                    float* dst = F + (gk == 0 ? O_KVP0 : (gk == 1 ? O_KVP1 : O_KVP2)) + ((size_t)(bb * win + i) * 2 + s2) * 512 + hd;
                                    __builtin_nontemporal_store(v0, (f32x4*)dst); __builtin_nontemporal_store(v1, (f32x4*)(dst + 4));
                                }
                            }
                        } else *(u32x4*)(O + row * ldc + col) = w;
                    }
                }
            }
    }
};

template <class EpiT, class Sched>
__device__ __forceinline__ void gemm_phase(LAS unsigned char* lds, const Gemm g, const Sched& S, const EpiT& E) {
    const int tid = threadIdx.x, wid = __builtin_amdgcn_readfirstlane(tid >> 6), lane = tid & 63, wr = wid >> 2, wc = wid & 3, fr = lane & 15, fq = lane >> 4;
    const int nt = g.K / BK;
    unsigned voffA[2], voffB[2];
#pragma unroll
    for (int i = 0; i < 2; ++i) { int R, C; stage_rc(tid * 16 + i * 8192, R, C); const int Rb = EpiT::PERM ? ((R & ~31) + perm32(R & 31)) : R;
        voffA[i] = (unsigned)(R * g.lda + C) * 2u; voffB[i] = (unsigned)(Rb * g.ldb + C) * 2u; }
    const size_t kstep = (size_t)(BK * 2);
    const size_t hstepA = (size_t)HALF * g.lda * 2, hstepB = (size_t)HALF * g.ldb * 2;
    const size_t tstepA = 2 * hstepA, tstepB = 2 * hstepB;
    const unsigned ldsw = (unsigned)wid * 1024u;
    const int aoff = lds_byte(wr * 64 + fr, fq * 8), boff = lds_byte(wc * 32 + fr, fq * 8);
#define PG8_SA(b, h) (((b) * 2 + (h)) * HTB)
#define PG8_SB(b, h) ((4 + (b) * 2 + (h)) * HTB)
#define PG8_STAGE(bufoff, gbase, voff) do { _Pragma("unroll") for (int _i = 0; _i < 2; ++_i) \
        __builtin_amdgcn_global_load_lds((const unsigned*)((const char*)(gbase) + (voff)[_i]), (LAS unsigned*)(lds + (bufoff) + ldsw + _i * 8192), 16, 0, 0); } while (0)
#define PG8_LDA(dst, b, h) do { _Pragma("unroll") for (int m = 0; m < 4; ++m) _Pragma("unroll") for (int k = 0; k < 2; ++k) dst[m][k] = *(const LAS bf16x8*)(lds + PG8_SA(b, h) + aoff + m * 2048 + k * 1024); } while (0)
#define PG8_LDB(dst, b, h) do { _Pragma("unroll") for (int n = 0; n < 2; ++n) _Pragma("unroll") for (int k = 0; k < 2; ++k) dst[n][k] = *(const LAS bf16x8*)(lds + PG8_SB(b, h) + boff + n * 2048 + k * 1024); } while (0)
#define PG8_MMA(ai, bj, At, Bt) do { __builtin_amdgcn_s_setprio(1); _Pragma("unroll") for (int m = 0; m < 4; ++m) _Pragma("unroll") for (int n = 0; n < 2; ++n) _Pragma("unroll") for (int k = 0; k < 2; ++k) \
        acc[ai][bj][m][n] = __builtin_amdgcn_mfma_f32_16x16x32_bf16(Bt[n][k], At[m][k], acc[ai][bj][m][n], 0, 0, 0); __builtin_amdgcn_s_setprio(0); } while (0)
#define PG8_WAIT_V(n) asm volatile("s_waitcnt vmcnt(" #n ")" ::: "memory")
#define PG8_WAIT_L(n) asm volatile("s_waitcnt lgkmcnt(" #n ")" ::: "memory")
#define PG8_BAR __builtin_amdgcn_s_barrier()
#define PG8_SCHED __builtin_amdgcn_sched_barrier(0)
    Unit cur, nxt; int ui = 0;
    if (!S.next(0, cur)) return;
    f32x4 acc[2][2][4][2];
#pragma unroll
    for (int a = 0; a < 2; ++a)
#pragma unroll
        for (int b = 0; b < 2; ++b)
#pragma unroll
            for (int m = 0; m < 4; ++m)
#pragma unroll
                for (int n = 0; n < 2; ++n) acc[a][b][m][n] = (f32x4){0.f, 0.f, 0.f, 0.f};
    bf16x8 At[4][2], B0[2][2], B1[2][2];
    const char* cA = (const char*)g.A + (size_t)cur.pm * tstepA; const char* cB = (const char*)g.Bt + (size_t)cur.pn * tstepB;
    PG8_STAGE(PG8_SB(0, 0), cB, voffB); PG8_STAGE(PG8_SB(0, 1), cB + hstepB, voffB); PG8_STAGE(PG8_SA(0, 0), cA, voffA); PG8_STAGE(PG8_SA(0, 1), cA + hstepA, voffA);
    if (wr == 1) PG8_BAR;
    PG8_WAIT_V(2); PG8_BAR;
    PG8_STAGE(PG8_SB(1, 0), cB + kstep, voffB); PG8_STAGE(PG8_SA(1, 0), cA + kstep, voffA); PG8_STAGE(PG8_SB(1, 1), cB + hstepB + kstep, voffB);
    PG8_WAIT_V(6); PG8_BAR;
    for (;;) {
        const bool has_next = S.next(ui + 1, nxt);
        const char* nA = has_next ? (const char*)g.A + (size_t)nxt.pm * tstepA : cA; const char* nB = has_next ? (const char*)g.Bt + (size_t)nxt.pn * tstepB : cB;
        for (int t = 0; t < nt; t += 2) {
            const bool last = (t == nt - 2);
            const char* a1 = cA + (size_t)(t + 1) * kstep;
            const char* a2 = last ? nA : cA + (size_t)(t + 2) * kstep; const char* b2 = last ? nB : cB + (size_t)(t + 2) * kstep;
            const char* a3 = a2 + kstep; const char* b3 = b2 + kstep;
            PG8_LDB(B0, 0, 0); PG8_LDB(B1, 0, 1); PG8_SCHED; PG8_LDA(At, 0, 0); PG8_STAGE(PG8_SA(1, 1), a1 + hstepA, voffA);
            PG8_WAIT_V(8); PG8_WAIT_L(0); PG8_BAR; PG8_MMA(0, 0, At, B0); PG8_MMA(0, 1, At, B1); PG8_BAR; PG8_SCHED;
            PG8_LDA(At, 0, 1); PG8_STAGE(PG8_SB(0, 0), b2, voffB); PG8_STAGE(PG8_SB(0, 1), b2 + hstepB, voffB); PG8_STAGE(PG8_SA(0, 0), a2, voffA);
            PG8_WAIT_V(8); PG8_WAIT_L(0); PG8_BAR; PG8_MMA(1, 0, At, B0); PG8_MMA(1, 1, At, B1); PG8_BAR; PG8_SCHED;
            PG8_LDB(B0, 1, 0); PG8_LDB(B1, 1, 1); PG8_SCHED; PG8_LDA(At, 1, 0); PG8_STAGE(PG8_SA(0, 1), a2 + hstepA, voffA);
            PG8_WAIT_V(8); PG8_WAIT_L(0); PG8_BAR; PG8_MMA(0, 0, At, B0); PG8_MMA(0, 1, At, B1); PG8_BAR; PG8_SCHED;
            PG8_LDA(At, 1, 1); PG8_STAGE(PG8_SB(1, 0), b3, voffB); PG8_STAGE(PG8_SB(1, 1), b3 + hstepB, voffB); PG8_STAGE(PG8_SA(1, 0), a3, voffA);
            PG8_WAIT_V(8); PG8_WAIT_L(0); PG8_BAR; PG8_MMA(1, 0, At, B0); PG8_MMA(1, 1, At, B1); PG8_BAR; PG8_SCHED;
        }
        if (wr == 0) PG8_BAR;
        E(acc, cur, wr, wc, fr, fq);
        if (!has_next) break;
#pragma unroll
        for (int a = 0; a < 2; ++a)
#pragma unroll
            for (int b = 0; b < 2; ++b)
#pragma unroll
                for (int m = 0; m < 4; ++m)
#pragma unroll
                    for (int n = 0; n < 2; ++n) acc[a][b][m][n] = (f32x4){0.f, 0.f, 0.f, 0.f};
        cur = nxt; cA = nA; cB = nB; ++ui;
        if (wr == 1) PG8_BAR;
    }
    PG8_WAIT_V(0);
    PG8_BAR;
#undef PG8_SA
#undef PG8_SB
#undef PG8_STAGE
#undef PG8_LDA
#undef PG8_LDB
#undef PG8_MMA
#undef PG8_WAIT_V
#undef PG8_WAIT_L
#undef PG8_BAR
#undef PG8_SCHED
}
}

#define XB_TMO      128
#define XB_XCNT(j)  (256  + 64 * (j))
#define XB_XSUB(j)  (1280 + 64 * (j))
#define XB_XGEN(j)  (2304 + 64 * (j))
#define XB_TOP      3328
#define XB_TOPGEN   3392
#define XCD_BAR_WORDS 3456
#define XB_SPIN_CAP (1u << 18)
__device__ __forceinline__ unsigned xb_ld(unsigned* p)              { return __hip_atomic_load(p, __ATOMIC_RELAXED, __HIP_MEMORY_SCOPE_AGENT); }
__device__ __forceinline__ unsigned xb_add(unsigned* p, unsigned v) { return __hip_atomic_fetch_add(p, v, __ATOMIC_RELAXED, __HIP_MEMORY_SCOPE_AGENT); }
__device__ __forceinline__ unsigned xb_xcc_id() { return (unsigned)__builtin_amdgcn_s_getreg((3 << 11) | 20) & 0xFu; }
#define XB_SPIN(cond, bar) do { unsigned _sp = 0; while (cond) { __builtin_amdgcn_s_sleep(1); \
    if ((++_sp & 255u) == 0u) { if (xb_ld(&(bar)[XB_TMO])) break; if (_sp > XB_SPIN_CAP) { atomicAdd(&(bar)[XB_TMO], 1u); break; } } } } while (0)
struct XcdBarrier { unsigned* bar; unsigned x; volatile LAS unsigned* st; };
__device__ __forceinline__ XcdBarrier xcd_barrier_post(unsigned* bar, volatile LAS unsigned* st) {
    XcdBarrier b; b.bar = bar; b.x = xb_xcc_id(); b.st = st;
    if (threadIdx.x == 0) (void)xb_add(&bar[XB_XCNT(b.x)], 1u);
    return b;
}
__device__ __forceinline__ void xcd_barrier_complete(unsigned* bar, unsigned x, unsigned& nloc, unsigned& nx) {
    const unsigned G = gridDim.x * gridDim.y * gridDim.z;
    unsigned sum, cnt, mine, sp = 0u;
    for (;;) {
        sum = 0u; cnt = 0u; mine = 0u;
#pragma unroll
        for (unsigned j = 0; j < 16; ++j) { const unsigned c = xb_ld(&bar[XB_XCNT(j)]); sum += c; cnt += (c > 0u) ? 1u : 0u; mine = (j == x) ? c : mine; }
        if (sum == G) break;
        __builtin_amdgcn_s_sleep(1);
        if ((++sp & 255u) == 0u) { if (xb_ld(&bar[XB_TMO])) break; if (sp > XB_SPIN_CAP) { atomicAdd(&bar[XB_TMO], 1u); break; } }
    }
    nloc = mine > 0u ? mine : 1u; nx = cnt > 0u ? cnt : 1u;
}
__device__ __forceinline__ void xcd_barrier(const XcdBarrier& b) {
    asm volatile("s_waitcnt vmcnt(0)" ::: "memory");
    __syncthreads();
    if (threadIdx.x == 0) {
        unsigned* bar = b.bar;
        __builtin_amdgcn_s_waitcnt(0);
        unsigned nloc = b.st[0], nx = b.st[1];
        if (nloc == 0u) { xcd_barrier_complete(bar, b.x, nloc, nx); b.st[0] = nloc; b.st[1] = nx; }
        const unsigned old = xb_add(&bar[XB_XSUB(b.x)], 1u);
        const unsigned gen = old / nloc;
        if (old + 1u == (gen + 1u) * nloc) {
            __builtin_amdgcn_fence(__ATOMIC_RELEASE, "agent");
            asm volatile("s_waitcnt vmcnt(0)" ::: "memory");
            const unsigned og = xb_add(&bar[XB_TOP], 1u);
            const unsigned tg = og / nx;
            if (og + 1u == (tg + 1u) * nx) xb_add(&bar[XB_TOPGEN], 1u);
            else XB_SPIN(xb_ld(&bar[XB_TOPGEN]) == tg, bar);
            __builtin_amdgcn_fence(__ATOMIC_ACQUIRE, "agent");
            xb_add(&bar[XB_XGEN(b.x)], 1u);
            asm volatile("s_waitcnt vmcnt(0)" ::: "memory");
        } else {
            XB_SPIN(xb_ld(&bar[XB_XGEN(b.x)]) == gen, bar);
            __builtin_amdgcn_fence(__ATOMIC_ACQUIRE, "agent");
            asm volatile("s_waitcnt vmcnt(0)" ::: "memory");
        }
    }
    __syncthreads();
}

struct Args { const float* in[19]; float* out; unsigned char* ws; int ph_lo, ph_hi; };

__device__ __forceinline__ void transpose_item(const float* W, int ldw, int k0, int nsrc0, bf16_t* WT, int ldt, int dst_row0, int dst_k0, LAS float* scr, int lane) {
#pragma unroll 8
    for (int i = 0; i < 32; ++i) { const int kk = 2 * i + (lane >> 5); scr[kk * 33 + (lane & 31)] = W[(size_t)(k0 + kk) * ldw + nsrc0 + (lane & 31)]; }
    __builtin_amdgcn_fence(__ATOMIC_RELEASE, "wavefront"); asm volatile("s_waitcnt lgkmcnt(0)" ::: "memory");
    const int c = lane & 7;
#pragma unroll
    for (int j = 0; j < 4; ++j) { const int n = (lane >> 3) + 8 * j; const LAS float* s = scr + (8 * c) * 33 + n;
        u32x4 o; o.x = cvt_pk_bf16(s[0 * 33], s[1 * 33]); o.y = cvt_pk_bf16(s[2 * 33], s[3 * 33]); o.z = cvt_pk_bf16(s[4 * 33], s[5 * 33]); o.w = cvt_pk_bf16(s[6 * 33], s[7 * 33]);
        *(u32x4*)(WT + (size_t)(dst_row0 + n) * ldt + dst_k0 + k0 + 8 * c) = o; }
    asm volatile("s_waitcnt lgkmcnt(0)" ::: "memory");
}

constexpr unsigned CP_PERB = 2040u * 256u, CP_TOT = CP_PERB * 32u;
constexpr unsigned CP_S1 = 3000000u, CP_S2 = 8000000u, CP_S3 = 12000000u, CP_S4 = 15000000u;
static_assert(CP_S4 <= CP_TOT, "slices within the copy");
__device__ __forceinline__ void copy_g2_range(const Args& a, unsigned lo, unsigned hi, int sb, int nsb) {
    const unsigned T = (unsigned)nsb * 512u, t0 = lo + (unsigned)sb * 512u + threadIdx.x;
    const f32x4* __restrict__ src = (const f32x4*)a.in[5]; f32x4* __restrict__ dst = (f32x4*)(a.out + O_KVS2);
    for (unsigned i0 = t0; i0 < hi; i0 += 16u * T) {
        f32x4 v[16];
#pragma unroll
        for (int u = 0; u < 16; ++u) { const unsigned i = i0 + u * T; if (i < hi) { const unsigned bb = i / CP_PERB, o = i - bb * CP_PERB; v[u] = __builtin_nontemporal_load(src + (size_t)bb * (2048u * 256u) + 2048u + o); } }
#pragma unroll
        for (int u = 0; u < 16; ++u) { const unsigned i = i0 + u * T; if (i < hi) { const unsigned bb = i / CP_PERB, o = i - bb * CP_PERB; __builtin_nontemporal_store(v[u], dst + (size_t)bb * (2048u * 256u) + o); } }
    }
}
__device__ __forceinline__ void p0_prologue(const Args& a, LAS unsigned char* lds) {
    const int tid = threadIdx.x, lane = tid & 63, wave = __builtin_amdgcn_readfirstlane(tid >> 6);
    const int G = gridDim.x, gw = blockIdx.x * 8 + wave, NGW = G * 8;
    unsigned char* ws = a.ws;
    LAS float* WGL = (LAS float*)lds;
    const float* w_in = a.in[10];
    for (int e = tid; e < 16384; e += 512) { const int k = e >> 4, r = e & 15; WGL[r * 1028 + k] = w_in[(size_t)k * WIN_W + 3072 + r]; }
    __syncthreads();
    {
        const float* g_pre = a.in[8];
        f32x4 gp[4];
#pragma unroll
        for (int j = 0; j < 4; ++j) gp[j] = *(const f32x4*)(g_pre + 4 * lane + 256 * j);
        bf16_t* XN = (bf16_t*)(ws + WS_XN); float* GLR = (float*)(ws + WS_GLR);
        f32x4 vn[4];
        if (gw < M) { const float* xr = (gw < MP) ? a.in[0] + (size_t)gw * DM : a.in[1] + (size_t)(gw - MP) * DM;
#pragma unroll
            for (int j = 0; j < 4; ++j) vn[j] = *(const f32x4*)(xr + 4 * lane + 256 * j); }
        for (int m = gw; m < M; m += NGW) {
            f32x4 v[4]; float ss = 0.f;
#pragma unroll
            for (int j = 0; j < 4; ++j) { v[j] = vn[j]; ss += (v[j].x * v[j].x + v[j].y * v[j].y) + (v[j].z * v[j].z + v[j].w * v[j].w); }
            { const int mn = m + NGW; if (mn < M) { const float* xr = (mn < MP) ? a.in[0] + (size_t)mn * DM : a.in[1] + (size_t)(mn - MP) * DM;
#pragma unroll
                for (int j = 0; j < 4; ++j) vn[j] = *(const f32x4*)(xr + 4 * lane + 256 * j); } }
            const float rs = rsqrtf(wave_sum(ss) * (1.f / DM) + NORM_EPS);
#pragma unroll
            for (int j = 0; j < 4; ++j) { v[j] = v[j] * rs * gp[j];
                u32x2 o; o.x = cvt_pk_bf16(v[j].x, v[j].y); o.y = cvt_pk_bf16(v[j].z, v[j].w);
                *(u32x2*)(XN + (size_t)m * DM + 4 * lane + 256 * j) = o; }
            float mine = 0.f;
#pragma unroll 2
            for (int r = 0; r < 16; ++r) {
                float p = 0.f;
#pragma unroll
                for (int j = 0; j < 4; ++j) { const f32x4 w4 = *(const LAS f32x4*)(WGL + r * 1028 + 4 * lane + 256 * j); p += (v[j].x * w4.x + v[j].y * w4.y) + (v[j].z * w4.z + v[j].w * w4.w); }
                p = row16_sum(p);
                if ((lane & 15) == r) mine = p;
            }
            mine += __shfl_xor(mine, 16); mine += __shfl_xor(mine, 32);
            if (lane < 16) GLR[(size_t)m * 16 + lane] = mine;
        }
    }
    __syncthreads();
    {
        LAS float* scr = (LAS float*)(lds + 65792 + wave * 8448);
        constexpr int I_IN = 16 * 320, I_GA = 16 * 32, I_DB = 8 * 32, I_O = 16 * 32, I_G = 16 * 32, I_P = 4 * 32;
        constexpr int NIT = I_IN + I_GA + I_DB + I_O + I_G + I_P;
        for (int it = gw; it < NIT; it += NGW) {
            int r = it;
            if (r < I_IN) { const int kb = r / 320, nb = r % 320, nd = 32 * nb; transpose_item(w_in, WIN_W, 64 * kb, nd + (nd >= 3072 ? 16 : 0), (bf16_t*)(ws + WS_WIN), 1024, nd, 0, scr, lane); continue; } r -= I_IN;
            if (r < I_GA) { const int kb = r / 32, nb = r % 32; transpose_item(a.in[14], 1024, 64 * kb, 32 * nb, (bf16_t*)(ws + WS_WAB), 1536, 32 * nb, 0, scr, lane); continue; } r -= I_GA;
            if (r < I_DB) { const int kb = r / 32, nb = r % 32; transpose_item(a.in[15], 1024, 64 * kb, 32 * nb, (bf16_t*)(ws + WS_WAB), 1536, 32 * nb, 1024, scr, lane); continue; } r -= I_DB;
            if (r < I_O) { const int kb = r / 32, nb = r % 32; transpose_item(a.in[16], 1024, 64 * kb, 32 * nb, (bf16_t*)(ws + WS_WO), 1024, 32 * nb, 0, scr, lane); continue; } r -= I_O;
            if (r < I_G) { const int kb = r / 32, nb = r % 32; transpose_item(a.in[18], 1024, 64 * kb, 32 * nb, (bf16_t*)(ws + WS_WG), 1024, 32 * nb, 0, scr, lane); continue; } r -= I_G;
            { const int kb = r / 32, nb = r % 32; transpose_item(a.in[17], 1024, 64 * kb, 32 * nb, (bf16_t*)(ws + WS_WP), 256, 32 * nb, 0, scr, lane); }
        }
    }
    {
        u32x2* __restrict__ PE = (u32x2*)(ws + WS_PE);
        const size_t n4 = (size_t)M * 256 / 4, np4 = (size_t)MP * 256 / 4;
        const f32x4* __restrict__ p0 = (const f32x4*)a.in[6]; const f32x4* __restrict__ p1 = (const f32x4*)a.in[7];
        const size_t T = (size_t)G * 512, t0 = (size_t)blockIdx.x * 512 + tid;
        for (size_t i0 = t0; i0 < n4; i0 += 8 * T) {
            f32x4 v[8];
#pragma unroll
            for (int u = 0; u < 8; ++u) { const size_t i = i0 + u * T; if (i < n4) v[u] = (i < np4) ? p0[i] : p1[i - np4]; }
#pragma unroll
            for (int u = 0; u < 8; ++u) { const size_t i = i0 + u * T; if (i < n4) { u32x2 o; o.x = cvt_pk_bf16(v[u].x, v[u].y); o.y = cvt_pk_bf16(v[u].z, v[u].w); PE[i] = o; } }
        }
    }
    copy_g2_range(a, (G == 256) ? CP_S4 : 0u, CP_TOT, blockIdx.x, G);
    {
        const unsigned T = (unsigned)G * 512u, t0 = (unsigned)blockIdx.x * 512u + tid;
#pragma unroll
        for (int g = 1; g >= 0; --g) {
            const unsigned Lb = (g == 0) ? 128u : 512u;
            const f32x4* __restrict__ src = (const f32x4*)a.in[3 + g]; f32x4* __restrict__ dst = (f32x4*)(a.out + (g == 0 ? O_KVS0 : O_KVS1));
            const unsigned per_b = (Lb - 8u) * 256u, tot = per_b * (unsigned)DECB;
            for (unsigned i0 = t0; i0 < tot; i0 += 16u * T) {
                f32x4 v[16];
#pragma unroll
                for (int u = 0; u < 16; ++u) { const unsigned i = i0 + u * T; if (i < tot) { const unsigned bb = i / per_b, o = i - bb * per_b; v[u] = __builtin_nontemporal_load(src + (size_t)bb * (Lb * 256u) + 2048u + o); } }
#pragma unroll
                for (int u = 0; u < 16; ++u) { const unsigned i = i0 + u * T; if (i < tot) { const unsigned bb = i / per_b, o = i - bb * per_b; __builtin_nontemporal_store(v[u], dst + (size_t)bb * (Lb * 256u) + o); } }
            }
        }
    }
}

constexpr int KST = 272, VSA = 288;
static_assert(256 * KST + 256 * VSA <= LDS_BYTES - 32, "attention tiles fit under the control words");
constexpr int KST_DUMMY = 0;
struct AttnHalf { u32x4 k[4], v[4]; };
__device__ __forceinline__ void ah_issue(AttnHalf& H, const bf16_t* U, size_t rowbase, int dil, int lbase, int colk, int colv, int tid) {
#pragma unroll
    for (int i = 0; i < 4; ++i) {
        const int c = tid + 512 * i, row = c >> 4, ch = c & 15, l = lbase + row;
        if (l >= 0) { const bf16_t* p = U + (rowbase + (size_t)l * dil) * NU + 8 * ch; H.k[i] = __builtin_nontemporal_load((const u32x4*)(p + colk)); H.v[i] = __builtin_nontemporal_load((const u32x4*)(p + colv)); }
        else { H.k[i] = (u32x4){0u, 0u, 0u, 0u}; H.v[i] = (u32x4){0u, 0u, 0u, 0u}; }
    }
}
__device__ __forceinline__ void ah_store(LAS unsigned char* lds, const AttnHalf& H, int half, int tid) {
    LAS unsigned char* Ks = lds; LAS unsigned char* Vs = lds + 256 * KST;
#pragma unroll
    for (int i = 0; i < 4; ++i) { const int c = tid + 512 * i, row = half * 128 + (c >> 4), ch = c & 15; *(LAS u32x4*)(Ks + row * KST + 16 * ch) = H.k[i]; *(LAS u32x4*)(Vs + row * VSA + 16 * ch) = H.v[i]; }
}
__device__ __forceinline__ void attn_block(LAS unsigned char* lds, const bf16x8 (&qf)[4], bf16_t* OG, float* LSE, int g, int h, size_t rowbase, int dil, int l0, int hp, int tid) {
    const int lane = tid & 63, w = __builtin_amdgcn_readfirstlane(tid >> 6), qi = lane & 15, gq = lane >> 4;
    LAS unsigned char* Ks = lds; LAS unsigned char* Vs = lds + 256 * KST;
    const int lq = l0 + 16 * w + qi;
    const size_t mq = rowbase + (size_t)lq * dil;
    int trow[10];
#pragma unroll
    for (int t = 0; t < 10; ++t) { const int lt = w + (t < 9 ? t : 8); trow[t] = (((lt >> 3) ? (hp ^ 1) : hp) << 7) + ((lt & 7) << 4); }
    f32x4 sc[9];
#pragma unroll
    for (int kt = 0; kt < 9; ++kt) {
        f32x4 acc = {0.f, 0.f, 0.f, 0.f};
#pragma unroll
        for (int s = 0; s < 4; ++s) { const bf16x8 ka = *(const LAS bf16x8*)(Ks + (trow[kt] + qi) * KST + 64 * s + 16 * gq); acc = MFMA16(ka, qf[s], acc); }
        sc[kt] = acc;
    }
    float mx = -INFINITY;
#pragma unroll
    for (int kt = 0; kt < 9; ++kt)
#pragma unroll
        for (int jj = 0; jj < 4; ++jj) {
            const int diff = 128 + qi - 16 * kt - 4 * gq - jj; const bool valid = (diff >= 0) && (diff <= 128) && (lq - diff >= 0);
            const float s = valid ? sc[kt][jj] * QSCALE : -INFINITY; sc[kt][jj] = s; mx = fmaxf(mx, s);
        }
    mx = fmaxf(mx, __shfl_xor(mx, 16)); mx = fmaxf(mx, __shfl_xor(mx, 32));
    float sum = 0.f;
#pragma unroll
    for (int kt = 0; kt < 9; ++kt)
#pragma unroll
        for (int jj = 0; jj < 4; ++jj) { const float p = __expf(sc[kt][jj] - mx); sc[kt][jj] = p; sum += p; }
    sum += __shfl_xor(sum, 16); sum += __shfl_xor(sum, 32);
    const float inv = 1.0f / sum;
    bf16x8 pf[5];
#pragma unroll
    for (int a = 0; a < 5; ++a) {
        u32x4 t; t.x = cvt_pk_bf16(sc[2 * a][0], sc[2 * a][1]); t.y = cvt_pk_bf16(sc[2 * a][2], sc[2 * a][3]);
        if (a < 4) { t.z = cvt_pk_bf16(sc[2 * a + 1][0], sc[2 * a + 1][1]); t.w = cvt_pk_bf16(sc[2 * a + 1][2], sc[2 * a + 1][3]); } else { t.z = 0u; t.w = 0u; }
        pf[a] = __builtin_bit_cast(bf16x8, t);
    }
    const int q4 = qi >> 2, p4 = qi & 3;
    bf16_t* og = OG + ((size_t)g * M + mq) * 512 + h * 128 + 4 * gq;
#pragma unroll
    for (int c = 0; c < 8; ++c) {
        f32x4 o = {0.f, 0.f, 0.f, 0.f};
#pragma unroll
        for (int a = 0; a < 5; ++a) {
            const int r0 = trow[2 * a] + 4 * gq + q4, r1 = trow[2 * a + 1] + 4 * gq + q4;
            const s16x4 lo = tr_read(Vs + r0 * VSA + 32 * c + 8 * p4), hi = tr_read(Vs + r1 * VSA + 32 * c + 8 * p4);
            o = MFMA16(cat4(lo, hi), pf[a], o);
        }
        u32x2 st; st.x = cvt_pk_bf16(o[0] * inv, o[1] * inv); st.y = cvt_pk_bf16(o[2] * inv, o[3] * inv);
        *(u32x2*)(og + 16 * c) = st;
    }
    if (gq == 0) LSE[((size_t)g * M + mq) * 4 + h] = mx + __logf(sum);
}
constexpr int ATT_ITEMS = 768;
__device__ __forceinline__ void attn_prompt_item(LAS unsigned char* lds, const bf16_t* U, bf16_t* OG, float* LSE, int item) {
    const int tid = opaque_tid(), lane = tid & 63, w = __builtin_amdgcn_readfirstlane(tid >> 6), qi = lane & 15, gq = lane >> 4;
    int g, bh, cls, qb0, nst;
    if (item < 256) { bh = item >> 3; const int r = item & 7; if (r < 4) { g = 0; cls = 0; qb0 = 8 * r; } else { g = 1; cls = r - 4; qb0 = 0; } nst = 8; }
    else { const int i2 = item - 256; bh = i2 >> 4; g = 2; cls = i2 & 15; qb0 = 0; nst = 2; }
    const int h = bh & 3, b = bh >> 2, dil = 1 << (2 * g);
    const size_t rowbase = (size_t)b * SEQ + cls;
    const int colk = UDK + g * 512 + h * 128, colv = UDV + g * 512 + h * 128, colq = UDQ + g * 512 + h * 128;
    AttnHalf H;
    bf16x8 qf[4], qn[4];
    int l0 = qb0 * 128;
    {
        AttnHalf P;
        ah_issue(P, U, rowbase, dil, l0 - 128, colk, colv, tid);
        ah_issue(H, U, rowbase, dil, l0, colk, colv, tid);
        const size_t mq = rowbase + (size_t)(l0 + 16 * w + qi) * dil;
#pragma unroll
        for (int s = 0; s < 4; ++s) qf[s] = *(const bf16x8*)(U + mq * NU + colq + 32 * s + 8 * gq);
        ah_store(lds, P, 0, tid);
        ah_store(lds, H, 1, tid);
    }
    __syncthreads();
    for (int st = 0; st < nst; ++st) {
        const int hp = st & 1;
        const bool more = (st + 1 < nst);
        if (more) {
            ah_issue(H, U, rowbase, dil, l0 + 128, colk, colv, tid);
            const size_t mq = rowbase + (size_t)(l0 + 128 + 16 * w + qi) * dil;
#pragma unroll
            for (int s = 0; s < 4; ++s) qn[s] = *(const bf16x8*)(U + mq * NU + colq + 32 * s + 8 * gq);
        }
        attn_block(lds, qf, OG, LSE, g, h, rowbase, dil, l0, hp, tid);
        __syncthreads();
        if (more) {
            ah_store(lds, H, hp, tid);
#pragma unroll
            for (int s = 0; s < 4; ++s) qf[s] = qn[s];
            l0 += 128;
            __syncthreads();
        }
    }
}

constexpr int GP_QI = 0, GP_KD = 17408, GP_VV = 34816, GP_PS = 68608, GP_GL = 72704;
constexpr int VST2 = 528, VST = 144;
constexpr int PRE_CH = 4;
#define GP_LOAD(cc_) do { const size_t m0_ = (size_t)b * SEQ + (size_t)(cc_) * 64; \
    _Pragma("unroll") for (int jj = 0; jj < 8; ++jj) { const bf16_t* p = U + (m0_ + 8 * w + jj) * NU + h * 128 + 2 * lane; qn[jj] = *(const unsigned*)(p + UQ); kn[jj] = *(const unsigned*)(p + UK); } \
    _Pragma("unroll") for (int i = 0; i < 4; ++i) { const int ci = tid + 512 * i, row = ci >> 5, ch = ci & 31; vn[i] = *(const u32x4*)(U + (m0_ + row) * NU + UV + h * 256 + 8 * ch); } \
    gn = *(const f32x4*)(GLR + (m0_ + ((tid & 255) >> 2)) * 16 + 4 * (tid & 3)); } while (0)
__device__ __forceinline__ void gla_pre_item(LAS unsigned char* lds, const bf16_t* U, const float* GLR, const float* w_lr, const float* b_lr, bf16_t* QIN, bf16_t* KEND, float* DEC, bf16_t* OA, int item) {
    const int tid = opaque_tid(), lane = tid & 63, w = __builtin_amdgcn_readfirstlane(tid >> 6), qi = lane & 15, gq = lane >> 4, q4 = qi >> 2, p4 = qi & 3;
    const int c4 = item & (64 / PRE_CH - 1), h = (item / (64 / PRE_CH)) & 3, b = item / (256 / PRE_CH);
    float W0[16], W1[16];
    const int d0 = h * 128 + 2 * lane;
#pragma unroll
    for (int r = 0; r < 16; ++r) { const f32x2 t = *(const f32x2*)(w_lr + r * 512 + d0); W0[r] = t.x; W1[r] = t.y; }
    const f32x2 bias = *(const f32x2*)(b_lr + d0);
    LAS float* PS = (LAS float*)(lds + GP_PS); LAS float* GL = (LAS float*)(lds + GP_GL);
    const int it = w & 3, eh = w >> 2;
    unsigned qn[8], kn[8]; u32x4 vn[4]; f32x4 gn;
    GP_LOAD(c4 * PRE_CH);
    for (int cc = 0; cc < PRE_CH; ++cc) {
        const int c = c4 * PRE_CH + cc;
        const size_t m0 = (size_t)b * SEQ + c * 64;
        unsigned qv[8], kv[8];
#pragma unroll
        for (int jj = 0; jj < 8; ++jj) { qv[jj] = qn[jj]; kv[jj] = kn[jj]; }
#pragma unroll
        for (int i = 0; i < 4; ++i) { const int ci = tid + 512 * i, row = ci >> 5, ch = ci & 31; *(LAS u32x4*)(lds + GP_VV + row * VST2 + 16 * ch) = vn[i]; }
        *(LAS f32x4*)(GL + ((tid & 255) >> 2) * 16 + 4 * (tid & 3)) = gn;
        __syncthreads();
        GP_LOAD((cc + 1 < PRE_CH) ? c + 1 : c);
        float c0[8], c1[8]; float run0 = 0.f, run1 = 0.f;
#pragma unroll
        for (int jj = 0; jj < 8; ++jj) {
            const LAS float* gp = GL + (8 * w + jj) * 16;
            float z0 = bias.x, z1 = bias.y;
#pragma unroll
            for (int r4 = 0; r4 < 4; ++r4) { const f32x4 g4 = *(const LAS f32x4*)(gp + 4 * r4);
                z0 += g4.x * W0[4 * r4] + g4.y * W0[4 * r4 + 1] + g4.z * W0[4 * r4 + 2] + g4.w * W0[4 * r4 + 3];
                z1 += g4.x * W1[4 * r4] + g4.y * W1[4 * r4 + 1] + g4.z * W1[4 * r4 + 2] + g4.w * W1[4 * r4 + 3]; }
            run0 += logsigmoidf_(z0) * (1.f / 16.f); run1 += logsigmoidf_(z1) * (1.f / 16.f); c0[jj] = run0; c1[jj] = run1;
        }
        *(LAS f32x2*)(PS + w * 128 + 2 * lane) = (f32x2){run0, run1};
        __syncthreads();
        float off0 = 0.f, off1 = 0.f, tot0 = 0.f, tot1 = 0.f;
#pragma unroll
        for (int ww = 0; ww < 8; ++ww) { const f32x2 t = *(const LAS f32x2*)(PS + ww * 128 + 2 * lane); if (ww < w) { off0 += t.x; off1 += t.y; } tot0 += t.x; tot1 += t.y; }
        if (w == 0) *(f32x2*)(DEC + ((size_t)(b * 64 + c)) * 512 + h * 128 + 2 * lane) = (f32x2){__expf(tot0), __expf(tot1)};
#pragma unroll
        for (int jj = 0; jj < 8; ++jj) {
            const float b0 = off0 + c0[jj], b1 = off1 + c1[jj];
            const float q0 = bflo(qv[jj]), q1 = bfhi(qv[jj]), k0 = bflo(kv[jj]), k1 = bfhi(kv[jj]);
            const int ro = (8 * w + jj) * KST + 4 * lane;
            const unsigned qin = cvt_pk_bf16(q0 * __expf(b0) * QSCALE, q1 * __expf(b1) * QSCALE);
            *(LAS unsigned*)(lds + GP_QI + ro) = qin;
            *(LAS unsigned*)(lds + GP_KD + ro) = cvt_pk_bf16(k0 * __expf(-b0), k1 * __expf(-b1));
            const size_t go = (m0 + 8 * w + jj) * 512 + h * 128 + 2 * lane;
            *(unsigned*)(QIN + go) = qin;
            *(unsigned*)(KEND + go) = cvt_pk_bf16(k0 * __expf(tot0 - b0), k1 * __expf(tot1 - b1));
        }
        __syncthreads();
        bf16x8 qf[4];
#pragma unroll
        for (int s = 0; s < 4; ++s) qf[s] = *(const LAS bf16x8*)(lds + GP_QI + (16 * it + qi) * KST + 64 * s + 16 * gq);
        f32x4 at[4];
#pragma unroll
        for (int jt = 0; jt < 4; ++jt) {
            f32x4 acc = {0.f, 0.f, 0.f, 0.f};
            if (jt <= it) {
#pragma unroll
                for (int s = 0; s < 4; ++s) { const bf16x8 ka = *(const LAS bf16x8*)(lds + GP_KD + (16 * jt + qi) * KST + 64 * s + 16 * gq); acc = MFMA16(ka, qf[s], acc); }
#pragma unroll
                for (int jj = 0; jj < 4; ++jj) if (16 * jt + 4 * gq + jj > 16 * it + qi) acc[jj] = 0.f;
            }
            at[jt] = acc;
        }
        bf16x8 pf[2];
#pragma unroll
        for (int a = 0; a < 2; ++a) { u32x4 t; t.x = cvt_pk_bf16(at[2 * a][0], at[2 * a][1]); t.y = cvt_pk_bf16(at[2 * a][2], at[2 * a][3]); t.z = cvt_pk_bf16(at[2 * a + 1][0], at[2 * a + 1][1]); t.w = cvt_pk_bf16(at[2 * a + 1][2], at[2 * a + 1][3]); pf[a] = __builtin_bit_cast(bf16x8, t); }
#pragma unroll
        for (int e8 = 0; e8 < 8; ++e8) {
            const int et = 8 * eh + e8;
            f32x4 o = {0.f, 0.f, 0.f, 0.f};
#pragma unroll
            for (int a = 0; a < 2; ++a) {
                const int r0 = 32 * a + 4 * gq + q4;
                const s16x4 lo = tr_read(lds + GP_VV + r0 * VST2 + 32 * et + 8 * p4), hi = tr_read(lds + GP_VV + (r0 + 16) * VST2 + 32 * et + 8 * p4);
                o = MFMA16(cat4(lo, hi), pf[a], o);
            }
            u32x2 st; st.x = cvt_pk_bf16(o[0], o[1]); st.y = cvt_pk_bf16(o[2], o[3]);
            *(u32x2*)(OA + (m0 + 16 * it + qi) * 1024 + h * 256 + 16 * et + 4 * gq) = st;
        }
        __syncthreads();
    }
}
#undef GP_LOAD

constexpr int GC_QI = 0, GC_KE = 17408, GC_VV = 34816, GC_DE = 44032, GC_BUF = 44544, GC_ST = 2 * GC_BUF;
#define GC_LOAD(cc, S) do { const size_t m0_ = (size_t)b * SEQ + (cc) * 64; \
    _Pragma("unroll") for (int i_ = 0; i_ < 2; ++i_) { const int ci_ = tid + 512 * i_, row_ = ci_ >> 4, ch_ = ci_ & 15; const size_t go_ = (m0_ + row_) * 512 + h * 128 + 8 * ch_; rq[S][i_] = *(const u32x4*)(QIN + go_); rk[S][i_] = *(const u32x4*)(KEND + go_); } \
    rv[S] = *(const u32x4*)(U + (m0_ + (tid >> 3)) * NU + UV + h * 256 + sl * 64 + 8 * (tid & 7)); \
    rd[S] = (tid < 128) ? DEC[((size_t)(b * 64 + (cc))) * 512 + h * 128 + tid] : 0.f; \
    { const bf16_t* op_ = OA + (m0_ + 16 * it + qi) * 1024 + h * 256 + sl * 64 + 32 * eh + 4 * gq; ro[S][0] = *(const u32x2*)op_; ro[S][1] = *(const u32x2*)(op_ + 16); } } while (0)
#define GC_STORE(bufo, S) do { \
    _Pragma("unroll") for (int i_ = 0; i_ < 2; ++i_) { const int ci_ = tid + 512 * i_, row_ = ci_ >> 4, ch_ = ci_ & 15; *(LAS u32x4*)(lds + (bufo) + GC_QI + row_ * KST + 16 * ch_) = rq[S][i_]; *(LAS u32x4*)(lds + (bufo) + GC_KE + row_ * KST + 16 * ch_) = rk[S][i_]; } \
    *(LAS u32x4*)(lds + (bufo) + GC_VV + (tid >> 3) * VST + 16 * (tid & 7)) = rv[S]; \
    if (tid < 128) *(LAS float*)(lds + (bufo) + GC_DE + 4 * tid) = rd[S]; } while (0)
__device__ __forceinline__ void gla_chain_item(LAS unsigned char* lds, const bf16_t* U, const bf16_t* QIN, const bf16_t* KEND, const float* DEC, bf16_t* OA, float* state_out, int item) {
    const int tid = opaque_tid(), lane = tid & 63, w = __builtin_amdgcn_readfirstlane(tid >> 6), qi = lane & 15, gq = lane >> 4, q4 = qi >> 2, p4 = qi & 3;
    const int sl = item & 3, h = (item >> 2) & 3, b = item >> 4;
    const int it = w & 3, eh = w >> 2;
    f32x4 accS[4];
#pragma unroll
    for (int et = 0; et < 4; ++et) accS[et] = (f32x4){0.f, 0.f, 0.f, 0.f};
    for (int i = tid; i < 17408 / 4; i += 512) ((LAS unsigned*)(lds + GC_ST))[i] = 0u;
    u32x4 rq[4][2], rk[4][2], rv[4]; float rd[4]; u32x2 ro[4][2];
    GC_LOAD(0, 0); GC_LOAD(1, 1); GC_LOAD(2, 2);
    GC_STORE(0, 0);
    __syncthreads();
    for (int c4 = 0; c4 < 64; c4 += 4) {
#pragma unroll
        for (int k = 0; k < 4; ++k) {
            const int c = c4 + k;
            const int bo = (k & 1) * GC_BUF;
            const size_t m0 = (size_t)b * SEQ + c * 64;
            if (c + 3 < 64) GC_LOAD(c + 3, (k + 3) & 3);
            bf16_t* op = OA + (m0 + 16 * it + qi) * 1024 + h * 256 + sl * 64 + 32 * eh + 4 * gq;
            bf16x8 qf[4];
#pragma unroll
            for (int s = 0; s < 4; ++s) qf[s] = *(const LAS bf16x8*)(lds + bo + GC_QI + (16 * it + qi) * KST + 64 * s + 16 * gq);
#pragma unroll
            for (int e2 = 0; e2 < 2; ++e2) {
                const int et = 2 * eh + e2;
                const u32x2 oi = ro[k][e2];
                f32x4 o = {bflo(oi.x), bfhi(oi.x), bflo(oi.y), bfhi(oi.y)};
#pragma unroll
                for (int s = 0; s < 4; ++s) { const bf16x8 sa = *(const LAS bf16x8*)(lds + GC_ST + (16 * et + qi) * KST + 64 * s + 16 * gq); o = MFMA16(sa, qf[s], o); }
                u32x2 st; st.x = cvt_pk_bf16(o[0], o[1]); st.y = cvt_pk_bf16(o[2], o[3]);
                *(u32x2*)(op + 16 * e2) = st;
            }
            {
                const f32x4 dec = *(const LAS f32x4*)(lds + bo + GC_DE + 4 * (16 * w + 4 * gq));
#pragma unroll
                for (int et = 0; et < 4; ++et) accS[et] = accS[et] * dec;
#pragma unroll
                for (int a = 0; a < 2; ++a) {
                    const int r0 = 32 * a + 8 * gq + q4;
                    const bf16x8 ka = cat4(tr_read(lds + bo + GC_KE + r0 * KST + 32 * w + 8 * p4), tr_read(lds + bo + GC_KE + (r0 + 4) * KST + 32 * w + 8 * p4));
#pragma unroll
                    for (int et = 0; et < 4; ++et) {
                        const bf16x8 vb = cat4(tr_read(lds + bo + GC_VV + r0 * VST + 32 * et + 8 * p4), tr_read(lds + bo + GC_VV + (r0 + 4) * VST + 32 * et + 8 * p4));
                        accS[et] = MFMA16(ka, vb, accS[et]);
                    }
                }
            }
            __syncthreads();
#pragma unroll
            for (int et = 0; et < 4; ++et) { u32x2 st; st.x = cvt_pk_bf16(accS[et][0], accS[et][1]); st.y = cvt_pk_bf16(accS[et][2], accS[et][3]);
                *(LAS u32x2*)(lds + GC_ST + (16 * et + qi) * KST + 2 * (16 * w + 4 * gq)) = st; }
            if (c + 1 < 64) GC_STORE(((k + 1) & 1) * GC_BUF, (k + 1) & 3);
            __syncthreads();
        }
    }
    float* so = state_out + ((size_t)(b * 4 + h) * 128) * 256 + sl * 64;
#pragma unroll
    for (int et = 0; et < 4; ++et)
#pragma unroll
        for (int jj = 0; jj < 4; ++jj) so[(size_t)(16 * w + 4 * gq + jj) * 256 + 16 * et + qi] = accS[et][jj];
    __syncthreads();
}

__device__ __forceinline__ void gla_sample_item(LAS unsigned char* lds, const bf16_t* U, const float* GLR, const float* w_lr, const float* b_lr, const float* state_in, bf16_t* OA, float* state_out, int item) {
    const int tid = opaque_tid(), lane = tid & 63, w = __builtin_amdgcn_readfirstlane(tid >> 6);
    const int h = item & 3, b = item >> 2;
    LAS float* LA = (LAS float*)lds;
    LAS float* QT = LA + 1024;
    LAS float* KT = QT + 1024;
    LAS float* KD = KT + 1024;
    LAS float* QF = KD + 1024;
    LAS float* EB = QF + 1024;
    LAS float* ATT = EB + 128;
    LAS float* VF = ATT + 64;
    LAS float* OP = VF + 2048;
    const size_t mrow = (size_t)MP + b * 8;
    const int d0 = 2 * lane;
    float q0, q1, k0, k1;
    {
        const size_t m = mrow + w;
        const bf16_t* p = U + m * NU + h * 128 + d0;
        const unsigned qv = *(const unsigned*)(p + UQ), kv = *(const unsigned*)(p + UK);
        q0 = bflo(qv); q1 = bfhi(qv); k0 = bflo(kv); k1 = bfhi(kv);
        float z0 = b_lr[h * 128 + d0], z1 = b_lr[h * 128 + d0 + 1];
#pragma unroll
        for (int r = 0; r < 16; ++r) { const float gr = GLR[m * 16 + r]; z0 += gr * w_lr[r * 512 + h * 128 + d0]; z1 += gr * w_lr[r * 512 + h * 128 + d0 + 1]; }
        LA[w * 128 + d0] = logsigmoidf_(z0) * (1.f / 16.f); LA[w * 128 + d0 + 1] = logsigmoidf_(z1) * (1.f / 16.f);
        const u32x2 vv = *(const u32x2*)(U + m * NU + UV + h * 256 + 4 * lane);
        *(LAS f32x4*)(VF + w * 256 + 4 * lane) = (f32x4){bflo(vv.x), bfhi(vv.x), bflo(vv.y), bfhi(vv.y)};
    }
    __syncthreads();
    {
        float b0 = 0.f, b1 = 0.f, t0 = 0.f, t1 = 0.f;
#pragma unroll
        for (int j = 0; j < 8; ++j) { const float a0 = LA[j * 128 + d0], a1 = LA[j * 128 + d0 + 1]; if (j <= w) { b0 += a0; b1 += a1; } t0 += a0; t1 += a1; }
        const float qa = q0 * __expf(b0) * QSCALE, qb = q1 * __expf(b1) * QSCALE;
        QF[w * 128 + d0] = qa; QF[w * 128 + d0 + 1] = qb; QT[d0 * 8 + w] = qa; QT[(d0 + 1) * 8 + w] = qb;
        KD[w * 128 + d0] = k0 * __expf(-b0); KD[w * 128 + d0 + 1] = k1 * __expf(-b1);
        KT[d0 * 8 + w] = k0 * __expf(t0 - b0); KT[(d0 + 1) * 8 + w] = k1 * __expf(t1 - b1);
        if (w == 0) { EB[d0] = __expf(t0); EB[d0 + 1] = __expf(t1); }
    }
    __syncthreads();
    {
        const int j = lane & 7, part = lane >> 3; float s = 0.f;
#pragma unroll
        for (int d = 0; d < 16; ++d) s += QF[w * 128 + part * 16 + d] * KD[j * 128 + part * 16 + d];
        s += __shfl_xor(s, 8); s += __shfl_xor(s, 16); s += __shfl_xor(s, 32);
        if (lane < 8) ATT[w * 8 + j] = (j <= w) ? s : 0.f;
    }
    __syncthreads();
    {
        const int e = tid & 255, dh = tid >> 8;
        float vj[8], ao[8];
#pragma unroll
        for (int j = 0; j < 8; ++j) { vj[j] = VF[j * 256 + e]; ao[j] = 0.f; }
        const float* sin_ = state_in + ((size_t)(b * 4 + h) * 128 + 64 * dh) * 256 + e;
        float* sout = state_out + ((size_t)(b * 4 + h) * 128 + 64 * dh) * 256 + e;
        float s0v[64];
#pragma unroll
        for (int d = 0; d < 64; ++d) s0v[d] = sin_[(size_t)d * 256];
#pragma unroll
        for (int d = 0; d < 64; ++d) {
            const float s0 = s0v[d];
            const int dd = 64 * dh + d;
            const f32x4 ka = *(const LAS f32x4*)(KT + dd * 8), kb = *(const LAS f32x4*)(KT + dd * 8 + 4);
            const f32x4 qa = *(const LAS f32x4*)(QT + dd * 8), qb = *(const LAS f32x4*)(QT + dd * 8 + 4);
            float sn = EB[dd] * s0;
            sn += ka.x * vj[0] + ka.y * vj[1] + ka.z * vj[2] + ka.w * vj[3] + kb.x * vj[4] + kb.y * vj[5] + kb.z * vj[6] + kb.w * vj[7];
            sout[(size_t)d * 256] = sn;
            ao[0] += qa.x * s0; ao[1] += qa.y * s0; ao[2] += qa.z * s0; ao[3] += qa.w * s0; ao[4] += qb.x * s0; ao[5] += qb.y * s0; ao[6] += qb.z * s0; ao[7] += qb.w * s0;
        }
        if (dh == 1) {
#pragma unroll
            for (int i = 0; i < 8; ++i) OP[i * 256 + e] = ao[i];
        }
        __syncthreads();
        if (dh == 0) {
#pragma unroll
            for (int i = 0; i < 8; ++i) {
                float o = ao[i] + OP[i * 256 + e];
#pragma unroll
                for (int j = 0; j < 8; ++j) o += ATT[i * 8 + j] * vj[j];
                OA[(mrow + i) * 1024 + h * 256 + e] = (bf16_t)(cvt_pk_bf16(o, 0.f) & 0xffffu);
            }
        }
    }
    __syncthreads();
}

__device__ __forceinline__ void sa_load8(float (&x)[8], const bf16_t* U, const float* cb, size_t urow, int ucol, int Lb, int idx, int kv) {
    if (idx >= Lb) { const u32x4 t = *(const u32x4*)(U + (urow + (idx - Lb)) * NU + ucol);
        x[0] = bflo(t.x); x[1] = bfhi(t.x); x[2] = bflo(t.y); x[3] = bfhi(t.y); x[4] = bflo(t.z); x[5] = bfhi(t.z); x[6] = bflo(t.w); x[7] = bfhi(t.w); }
    else { const float* p = cb + ((size_t)idx * 2 + kv) * 512; const f32x4 a = *(const f32x4*)p, c = *(const f32x4*)(p + 4);
        x[0] = a.x; x[1] = a.y; x[2] = a.z; x[3] = a.w; x[4] = c.x; x[5] = c.y; x[6] = c.z; x[7] = c.w; }
}
__device__ __forceinline__ void attn_sample_item(LAS unsigned char* lds, const bf16_t* U, const float* cache, int g, int b, int t, bf16_t* OG, float* LSE) {
    const int tid = opaque_tid(), lane = tid & 63, w = __builtin_amdgcn_readfirstlane(tid >> 6), hh = lane >> 4, l16 = lane & 15;
    const int Lb = (g == 0) ? 128 : (g == 1 ? 512 : 2048), dil = 1 << (2 * g);
    LAS float* SCW = (LAS float*)lds + (w * 4 + hh) * 32;
    LAS float* OW = (LAS float*)lds + 1024;
    LAS float* MW = OW + 4096;
    LAS float* LW = MW + 32;
    const size_t mrow = (size_t)MP + b * 8;
    const int cq = UDQ + g * 512 + hh * 128 + 8 * l16, ck = UDK + g * 512 + hh * 128 + 8 * l16, cv = UDV + g * 512 + hh * 128 + 8 * l16;
    const float* cb = cache + (size_t)b * Lb * 1024 + hh * 128 + 8 * l16;
    float q[8];
    { const u32x4 qv = *(const u32x4*)(U + (mrow + t) * NU + cq);
      q[0] = bflo(qv.x); q[1] = bfhi(qv.x); q[2] = bflo(qv.y); q[3] = bfhi(qv.y); q[4] = bflo(qv.z); q[5] = bfhi(qv.z); q[6] = bflo(qv.w); q[7] = bfhi(qv.w); }
    const int nj = (w == 0) ? 17 : 16;
    {
        float x[8]; sa_load8(x, U, cb, mrow, ck, Lb, Lb + t - dil * w, 0);
        float s2 = 0.f;
#pragma unroll
        for (int e = 0; e < 8; ++e) s2 += q[e] * x[e];
        s2 += __shfl_xor(s2, 1); s2 += __shfl_xor(s2, 2); s2 += __shfl_xor(s2, 4); s2 += __shfl_xor(s2, 8);
        if (l16 == 0) SCW[0] = s2 * QSCALE;
    }
#pragma unroll 16
    for (int j = 1; j < 17; ++j) {
        const int m = w + 8 * j, mm = m > 128 ? 128 : m, idx = Lb + t - dil * mm;
        const float* p = cb + (size_t)idx * 1024; const f32x4 a = *(const f32x4*)p, c = *(const f32x4*)(p + 4);
        float s2 = (q[0] * a.x + q[1] * a.y) + (q[2] * a.z + q[3] * a.w) + (q[4] * c.x + q[5] * c.y) + (q[6] * c.z + q[7] * c.w);
        s2 += __shfl_xor(s2, 1); s2 += __shfl_xor(s2, 2); s2 += __shfl_xor(s2, 4); s2 += __shfl_xor(s2, 8);
        if (l16 == 0) SCW[j] = s2 * QSCALE;
    }
    __builtin_amdgcn_fence(__ATOMIC_RELEASE, "workgroup"); asm volatile("s_waitcnt lgkmcnt(0)" ::: "memory");
    float mx = -INFINITY;
    for (int j = 0; j < nj; ++j) mx = fmaxf(mx, SCW[j]);
    float l = 0.f, o[8];
#pragma unroll
    for (int e = 0; e < 8; ++e) o[e] = 0.f;
    {
        float x[8]; sa_load8(x, U, cb, mrow, cv, Lb, Lb + t - dil * w, 1);
        const float p = __expf(SCW[0] - mx); l += p;
#pragma unroll
        for (int e = 0; e < 8; ++e) o[e] += p * x[e];
    }
#pragma unroll 16
    for (int j = 1; j < 17; ++j) {
        const int m = w + 8 * j, mm = m > 128 ? 128 : m, idx = Lb + t - dil * mm;
        const float* p4 = cb + (size_t)idx * 1024 + 512; const f32x4 a = *(const f32x4*)p4, c = *(const f32x4*)(p4 + 4);
        const float p = (m <= 128) ? __expf(SCW[j] - mx) : 0.f; l += p;
        o[0] += p * a.x; o[1] += p * a.y; o[2] += p * a.z; o[3] += p * a.w; o[4] += p * c.x; o[5] += p * c.y; o[6] += p * c.z; o[7] += p * c.w;
    }
    {
        LAS float* op = OW + (w * 4 + hh) * 128 + 8 * l16;
        *(LAS f32x4*)op = (f32x4){o[0], o[1], o[2], o[3]}; *(LAS f32x4*)(op + 4) = (f32x4){o[4], o[5], o[6], o[7]};
        if (l16 == 0) { MW[w * 4 + hh] = mx; LW[w * 4 + hh] = l; }
    }
    __syncthreads();
    {
        const int h2 = tid >> 7, d = tid & 127;
        float Mx = -INFINITY;
#pragma unroll
        for (int ww = 0; ww < 8; ++ww) Mx = fmaxf(Mx, MW[ww * 4 + h2]);
        float L = 0.f, acc = 0.f;
#pragma unroll
        for (int ww = 0; ww < 8; ++ww) { const float f = __expf(MW[ww * 4 + h2] - Mx); L += LW[ww * 4 + h2] * f; acc += OW[(ww * 4 + h2) * 128 + d] * f; }
        OG[((size_t)g * M + mrow + t) * 512 + h2 * 128 + d] = (bf16_t)(cvt_pk_bf16(acc / L, 0.f) & 0xffffu);
        if (d == 0) LSE[((size_t)g * M + mrow + t) * 4 + h2] = Mx + __logf(L);
    }
    __syncthreads();
}

constexpr int KV_ROWS_P = 8 * (128 + 512 + 2048), KV_ROWS = KV_ROWS_P + 3 * 32 * 8, KV_ITEMS = (KV_ROWS + 63) / 64;
__device__ __forceinline__ void kvcopy_item(const bf16_t* __restrict__ U, float* __restrict__ out, int item) {
    const int tid = opaque_tid(), lane = tid & 63, w = tid >> 6;
    u32x4 v[8][2]; float* dstp[8];
#pragma unroll
    for (int rr = 0; rr < 8; ++rr) {
        int R = item * 64 + w * 8 + rr; if (R >= KV_ROWS) R = KV_ROWS - 1;
        int g; size_t m; float* dst;
        if (R < KV_ROWS_P) {
            int win;
            if (R < 8 * 128) { g = 0; win = 128; dst = out + O_KVP0; } else if (R < 8 * 640) { g = 1; win = 512; R -= 8 * 128; dst = out + O_KVP1; } else { g = 2; win = 2048; R -= 8 * 640; dst = out + O_KVP2; }
            const int b = R / win, i = R % win; m = (size_t)b * SEQ + SEQ - win + i; dst += (size_t)R * 1024;
        } else {
            R -= KV_ROWS_P; g = R / 256; R -= g * 256; const int b = R >> 3, t = R & 7; const int Lb = (g == 0) ? 128 : (g == 1 ? 512 : 2048);
            m = (size_t)MP + b * 8 + t; dst = out + (g == 0 ? O_KVS0 : (g == 1 ? O_KVS1 : O_KVS2)) + ((size_t)b * Lb + Lb - 8 + t) * 1024;
        }
        const bf16_t* src = U + m * NU + g * 512;
        v[rr][0] = *(const u32x4*)(src + UDK + 8 * lane); v[rr][1] = *(const u32x4*)(src + UDV + 8 * lane);
        dstp[rr] = dst;
    }
#pragma unroll
    for (int rr = 0; rr < 8; ++rr)
#pragma unroll
        for (int s2 = 0; s2 < 2; ++s2) {
            const u32x4 x = v[rr][s2];
            float* d = dstp[rr] + s2 * 512 + 8 * lane;
            *(f32x4*)d = (f32x4){bflo(x.x), bfhi(x.x), bflo(x.y), bfhi(x.y)}; *(f32x4*)(d + 4) = (f32x4){bflo(x.z), bfhi(x.z), bflo(x.w), bfhi(x.w)};
        }
}

constexpr int QA_PRE = 2048 / PRE_CH, QA_SATT = 768, QA_SGLA = 128;
constexpr int KV_ITEMS_P = KV_ROWS_P / 64;
static_assert(KV_ROWS_P % 64 == 0, "prompt kv rows fill whole items");
constexpr int QA0 = QA_PRE, QA1 = QA0 + QA_SATT, QA2 = QA1 + QA_SGLA, QA_TOTAL = QA2 + (KV_ITEMS - KV_ITEMS_P);
constexpr int QB_CHAIN = 128, QB_ATT = ATT_ITEMS, QB_TOTAL = QB_CHAIN + QB_ATT;

__device__ __forceinline__ void p2_queue(const Args& a, LAS unsigned char* lds, int which, int cslot, int qlo, int qhi) {
    unsigned char* ws = a.ws;
    const bf16_t* U = (const bf16_t*)(ws + WS_U); const float* GLR = (const float*)(ws + WS_GLR);
    bf16_t* OA = (bf16_t*)(ws + WS_OA); bf16_t* OG = (bf16_t*)(ws + WS_OG); float* LSE = (float*)(ws + WS_LSE);
    bf16_t* QIN = (bf16_t*)(ws + WS_XN); bf16_t* KEND = QIN + (size_t)MP * 512; float* DEC = (float*)(ws + WS_AB);
    unsigned* ctr = (unsigned*)(ws + WS_CTL) + 64 * cslot;
    LAS int* slot = (LAS int*)(lds + LDS_BYTES - 16);
    const int total0 = which ? QB_TOTAL : QA_TOTAL; const int total = qhi < total0 ? qhi : total0;
    for (;;) {
        if (threadIdx.x == 0) *slot = qlo + (int)atomicAdd(ctr, 1u);
        __syncthreads();
        const int it = *slot;
        __syncthreads();
        if (it >= total) break;
        if (which == 0) {
            if (it < QA_SATT) { const int r = it, t = r & 7, g = 2 - ((r >> 3) % 3), b = r / 24; attn_sample_item(lds, U, a.in[3 + g], g, b, t, OG, LSE); }
            else if (it < QA_SATT + QA_SGLA) gla_sample_item(lds, U, GLR, a.in[11], a.in[12], a.in[2], OA, a.out + O_SGS, it - QA_SATT);
            else if (it < QA2) gla_pre_item(lds, U, GLR, a.in[11], a.in[12], QIN, KEND, DEC, OA, it - QA_SATT - QA_SGLA);
            else kvcopy_item(U, a.out, KV_ITEMS_P + it - QA2);
        } else {
            if (it < QB_CHAIN) gla_chain_item(lds, U, QIN, KEND, DEC, OA, a.out + O_SGP, it);
            else attn_prompt_item(lds, U, OG, LSE, it - QB_CHAIN);
        }
    }
}

struct CmbRow { u32x2 oa[4], gg[4], og[3][2], dg[2]; float lse[3][2]; };
__device__ __forceinline__ void cmb_load(CmbRow& r, const bf16_t* __restrict__ U, const bf16_t* __restrict__ OA, const bf16_t* __restrict__ OG, const float* __restrict__ LSE, int m, int lane) {
    const bf16_t* ur = U + (size_t)m * NU;
#pragma unroll
    for (int j = 0; j < 4; ++j) { r.oa[j] = *(const u32x2*)(OA + (size_t)m * 1024 + 4 * lane + 256 * j); r.gg[j] = __builtin_nontemporal_load((const u32x2*)(ur + UG + 4 * lane + 256 * j)); }
#pragma unroll
    for (int j = 0; j < 2; ++j) {
        const int c = 4 * lane + 256 * j, h = c >> 7;
        r.dg[j] = __builtin_nontemporal_load((const u32x2*)(ur + UDG + c));
#pragma unroll
        for (int g = 0; g < 3; ++g) { r.og[g][j] = *(const u32x2*)(OG + ((size_t)g * M + m) * 512 + c); r.lse[g][j] = LSE[((size_t)g * M + m) * 4 + h]; }
    }
}
__device__ __forceinline__ void cmb_compute(const CmbRow& r, const f32x4 (&gv)[4], bf16_t* __restrict__ AB, int m, int lane) {
#pragma unroll
    for (int j = 0; j < 4; ++j) {
        f32x4 o = {bflo(r.oa[j].x), bfhi(r.oa[j].x), bflo(r.oa[j].y), bfhi(r.oa[j].y)};
        const float ss = wave_sum((o.x * o.x + o.y * o.y) + (o.z * o.z + o.w * o.w));
        const float rs = rsqrtf(ss * (1.f / 256.f) + NORM_EPS);
        o = o * rs * gv[j];
        o.x *= siluf_(bflo(r.gg[j].x)); o.y *= siluf_(bfhi(r.gg[j].x)); o.z *= siluf_(bflo(r.gg[j].y)); o.w *= siluf_(bfhi(r.gg[j].y));
        u32x2 st; st.x = cvt_pk_bf16(o.x, o.y); st.y = cvt_pk_bf16(o.z, o.w);
        *(u32x2*)(AB + (size_t)m * 1536 + 4 * lane + 256 * j) = st;
    }
#pragma unroll
    for (int j = 0; j < 2; ++j) {
        const int c = 4 * lane + 256 * j;
        const float l0 = r.lse[0][j], l1 = r.lse[1][j], l2 = r.lse[2][j];
        const float mx = fmaxf(l0, fmaxf(l1, l2));
        float w0 = __expf(l0 - mx), w1 = __expf(l1 - mx), w2 = __expf(l2 - mx); const float inv = 1.0f / (w0 + w1 + w2); w0 *= inv; w1 *= inv; w2 *= inv;
        const u32x2 a0 = r.og[0][j], a1 = r.og[1][j], a2 = r.og[2][j];
        f32x4 o;
        o.x = w0 * bflo(a0.x) + w1 * bflo(a1.x) + w2 * bflo(a2.x); o.y = w0 * bfhi(a0.x) + w1 * bfhi(a1.x) + w2 * bfhi(a2.x);
        o.z = w0 * bflo(a0.y) + w1 * bflo(a1.y) + w2 * bflo(a2.y); o.w = w0 * bfhi(a0.y) + w1 * bfhi(a1.y) + w2 * bfhi(a2.y);
        const u32x2 dg = r.dg[j];
        o.x *= siluf_(bflo(dg.x)); o.y *= siluf_(bfhi(dg.x)); o.z *= siluf_(bflo(dg.y)); o.w *= siluf_(bfhi(dg.y));
        u32x2 st; st.x = cvt_pk_bf16(o.x, o.y); st.y = cvt_pk_bf16(o.z, o.w);
        *(u32x2*)(AB + (size_t)m * 1536 + 1024 + c) = st;
    }
}
__device__ __forceinline__ void p2b_combine(const Args& a) {
    const int tid = threadIdx.x, lane = tid & 63, wave = tid >> 6;
    const int gw = blockIdx.x * 8 + wave, NGW = gridDim.x * 8;
    unsigned char* ws = a.ws;
    const bf16_t* U = (const bf16_t*)(ws + WS_U); const bf16_t* OA = (const bf16_t*)(ws + WS_OA); const bf16_t* OG = (const bf16_t*)(ws + WS_OG); const float* LSE = (const float*)(ws + WS_LSE);
    bf16_t* AB = (bf16_t*)(ws + WS_AB);
    const float* gn = a.in[13];
    f32x4 gv[4];
#pragma unroll
    for (int j = 0; j < 4; ++j) gv[j] = *(const f32x4*)(gn + 4 * lane + 256 * j);
    CmbRow r0, r1, r2, r3;
    int m = gw;
    const int N1 = NGW;
    if (m < M) cmb_load(r0, U, OA, OG, LSE, m, lane);
    if (m + N1 < M) cmb_load(r1, U, OA, OG, LSE, m + N1, lane);
    if (m + 2 * N1 < M) cmb_load(r2, U, OA, OG, LSE, m + 2 * N1, lane);
    for (; m < M; m += 4 * N1) {
        if (m + 3 * N1 < M) cmb_load(r3, U, OA, OG, LSE, m + 3 * N1, lane);
        cmb_compute(r0, gv, AB, m, lane);
        if (m + 4 * N1 < M) cmb_load(r0, U, OA, OG, LSE, m + 4 * N1, lane);
        if (m + N1 < M) cmb_compute(r1, gv, AB, m + N1, lane);
        if (m + 5 * N1 < M) cmb_load(r1, U, OA, OG, LSE, m + 5 * N1, lane);
        if (m + 2 * N1 < M) cmb_compute(r2, gv, AB, m + 2 * N1, lane);
        if (m + 6 * N1 < M) cmb_load(r2, U, OA, OG, LSE, m + 6 * N1, lane);
        if (m + 3 * N1 < M) cmb_compute(r3, gv, AB, m + 3 * N1, lane);
    }
}

struct PostRow { u32x2 t[4]; f32x4 x[4]; };
__device__ __forceinline__ void post_load(PostRow& r, const Args& a, const bf16_t* __restrict__ T, int m, int lane) {
    const float* __restrict__ xr = (m < MP) ? a.in[0] + (size_t)m * DM : a.in[1] + (size_t)(m - MP) * DM;
#pragma unroll
    for (int j = 0; j < 4; ++j) { r.t[j] = *(const u32x2*)(T + (size_t)m * 1024 + 4 * lane + 256 * j); r.x[j] = __builtin_nontemporal_load((const f32x4*)(xr + 4 * lane + 256 * j)); }
}
__device__ __forceinline__ void post_compute(const PostRow& r, const f32x4 (&gv)[4], bf16_t* __restrict__ HB, int m, int lane) {
    f32x4 t[4]; float ss = 0.f;
#pragma unroll
    for (int j = 0; j < 4; ++j) { const u32x2 tv = r.t[j]; t[j] = (f32x4){bflo(tv.x), bfhi(tv.x), bflo(tv.y), bfhi(tv.y)};
        ss += (t[j].x * t[j].x + t[j].y * t[j].y) + (t[j].z * t[j].z + t[j].w * t[j].w); }
    const float rs = rsqrtf(wave_sum(ss) * (1.f / DM) + NORM_EPS);
#pragma unroll
    for (int j = 0; j < 4; ++j) {
        const f32x4 hh = r.x[j] + t[j] * rs * gv[j];
        u32x2 st; st.x = cvt_pk_bf16(hh.x, hh.y); st.y = cvt_pk_bf16(hh.z, hh.w);
        *(u32x2*)(HB + (size_t)m * 1024 + 4 * lane + 256 * j) = st;
    }
}
__device__ __forceinline__ void p5_post(const Args& a) {
    const int tid = threadIdx.x, lane = tid & 63, wave = tid >> 6;
    const int gw = blockIdx.x * 8 + wave, N1 = gridDim.x * 8;
    unsigned char* ws = a.ws;
    const bf16_t* T = (const bf16_t*)(ws + WS_OA); bf16_t* HB = (bf16_t*)(ws + WS_AB);
    const float* gpost = a.in[9];
    f32x4 gv[4];
#pragma unroll
    for (int j = 0; j < 4; ++j) gv[j] = *(const f32x4*)(gpost + 4 * lane + 256 * j);
    PostRow r0, r1, r2, r3;
    int m = gw;
    if (m < M) post_load(r0, a, T, m, lane);
    if (m + N1 < M) post_load(r1, a, T, m + N1, lane);
    if (m + 2 * N1 < M) post_load(r2, a, T, m + 2 * N1, lane);
    for (; m < M; m += 4 * N1) {
        if (m + 3 * N1 < M) post_load(r3, a, T, m + 3 * N1, lane);
        post_compute(r0, gv, HB, m, lane);
        if (m + 4 * N1 < M) post_load(r0, a, T, m + 4 * N1, lane);
        if (m + N1 < M) post_compute(r1, gv, HB, m + N1, lane);
        if (m + 5 * N1 < M) post_load(r1, a, T, m + 5 * N1, lane);
        if (m + 2 * N1 < M) post_compute(r2, gv, HB, m + 2 * N1, lane);
        if (m + 6 * N1 < M) post_load(r2, a, T, m + 6 * N1, lane);
        if (m + 3 * N1 < M) post_compute(r3, gv, HB, m + 3 * N1, lane);
    }
}

constexpr int N_PHASES = 9;
__global__ void __launch_bounds__(512, 2) fwd_kernel(Args args) {
    extern __shared__ __attribute__((aligned(16))) unsigned char lds_raw[];
    LAS unsigned char* lds = (LAS unsigned char*)lds_raw;
    const int lo = args.ph_lo, hi = args.ph_hi;
    unsigned char* ws = args.ws;
    const int G = gridDim.x, bx = blockIdx.x;
#if MK_SINGLE
    cg::grid_group grid = cg::this_grid();
    if (threadIdx.x < 4) ((LAS unsigned*)(lds + LDS_BYTES - 32))[threadIdx.x] = 0u;
    __syncthreads();
    const XcdBarrier xbar = xcd_barrier_post((unsigned*)(ws + WS_CTL) + CW_BAR, (volatile LAS unsigned*)(lds + LDS_BYTES - 32));
    if (hi > 1000) grid.sync();
#define SEAM(k) do { if (lo <= (k) && (k) + 1 < hi) xcd_barrier(xbar); } while (0)
#define REPS(k) (((k) == PROBE_DUP) ? 2 : 1)
#define REPSEAM(rep, k) do { if ((rep) + 1 < REPS(k)) xcd_barrier(xbar); } while (0)
#else
#define SEAM(k) do { } while (0)
#define REPS(k) 1
#define REPSEAM(rep, k) do { } while (0)
#endif
#define IN(k) (lo <= (k) && (k) < hi)
    if (IN(0)) { for (int rep = 0; rep < REPS(0); ++rep) { p0_prologue(args, lds); REPSEAM(rep, 0); } SEAM(0); }
    if (IN(1)) {
        pg8::Gemm g{(const bf16_t*)(ws + WS_XN), (const bf16_t*)(ws + WS_WIN), 1024, 1024, 1024};
        pg8::StaticOrder S; S.init(M / 256, NU / 256, G, bx);
        pg8::Epi<4> E{(bf16_t*)(ws + WS_U), NU, nullptr, 0, args.out};
        for (int rep = 0; rep < REPS(1); ++rep) { pg8::gemm_phase(lds, g, S, E); REPSEAM(rep, 1); }
        if (G == 256 && bx >= 40) copy_g2_range(args, 0u, CP_S1, bx - 40, G - 40);
        SEAM(1);
    }
    if (IN(2) || IN(3)) {
        for (int pass = 0; pass < 3; ++pass) {
            int which, qlo = 0, qhi = 1 << 30, cslot;
            if (pass == 0) { if (PROBE_Q != 0 && PROBE_Q != 1) continue; which = PROBE_Q; qlo = PROBE_LO; qhi = PROBE_HI; cslot = 2; }
            else { which = pass - 1; cslot = which; if (!IN(2 + which)) continue; }
            p2_queue(args, lds, which, cslot, qlo, qhi);
#if MK_SINGLE
            if (pass < 2 || hi > 4) xcd_barrier(xbar);
#endif
        }
    }
    if (IN(4)) { for (int rep = 0; rep < REPS(4); ++rep) { p2b_combine(args); REPSEAM(rep, 4); } SEAM(4); }
    if (IN(5)) {
        pg8::StaticOrder S; S.init(M / 256, 4, G, bx);
        for (int rep = 0; rep < REPS(5); ++rep) {
        { pg8::Gemm g{(const bf16_t*)(ws + WS_AB), (const bf16_t*)(ws + WS_WAB), 1536, 1536, 1024};
          pg8::Epi<0> E{(bf16_t*)(ws + WS_XN), 1024, nullptr, 0, nullptr};
          pg8::gemm_phase(lds, g, S, E); }
        { pg8::Gemm g{(const bf16_t*)(ws + WS_AB) + 1024, (const bf16_t*)(ws + WS_WAB) + 1024, 1536, 1536, 512};
          pg8::Epi<5> E{(bf16_t*)(ws + WS_XN), 1024, (const bf16_t*)(ws + WS_U) + UGA, NU, nullptr};
          pg8::gemm_phase(lds, g, S, E); }
        REPSEAM(rep, 5); }
        if (G == 256 && bx >= 4) copy_g2_range(args, CP_S1, CP_S2, bx - 4, G - 4);
        SEAM(5);
    }
    if (IN(6)) {
        pg8::StaticOrder S; S.init(M / 256, 4, G, bx);
        if (PROBE_Q == 2) { pg8::Gemm g{(const bf16_t*)(ws + WS_XN), (const bf16_t*)(ws + WS_WO), 1024, 1024, 1024};
          pg8::Epi<0> E{(bf16_t*)(ws + WS_OA), 1024, nullptr, 0, nullptr};
          pg8::gemm_phase(lds, g, S, E); xcd_barrier(xbar); }
        for (int rep = 0; rep < REPS(6); ++rep) {
        { pg8::Gemm g{(const bf16_t*)(ws + WS_XN), (const bf16_t*)(ws + WS_WO), 1024, 1024, 1024};
          pg8::Epi<0> E{(bf16_t*)(ws + WS_OA), 1024, nullptr, 0, nullptr};
          pg8::gemm_phase(lds, g, S, E); }
        { pg8::Gemm g{(const bf16_t*)(ws + WS_PE), (const bf16_t*)(ws + WS_WP), 256, 256, 256};
          pg8::Epi<0> E{(bf16_t*)(ws + WS_OG), 1024, nullptr, 0, nullptr};
          pg8::gemm_phase(lds, g, S, E); }
        REPSEAM(rep, 6); }
        if (G == 256 && bx >= 4) copy_g2_range(args, CP_S2, CP_S3, bx - 4, G - 4);
        SEAM(6);
    }
    if (IN(7)) { for (int rep = 0; rep < REPS(7); ++rep) { p5_post(args); REPSEAM(rep, 7); } SEAM(7); }
    if (IN(8)) {
        pg8::StaticOrder S; S.init(M / 256, 4, G, bx);
        pg8::Gemm g{(const bf16_t*)(ws + WS_AB), (const bf16_t*)(ws + WS_WG), 1024, 1024, 1024};
        pg8::Epi<3> E{(bf16_t*)(ws + WS_OG), 1024, (const bf16_t*)(ws + WS_AB), 1024, args.out + O_Y};
        pg8::gemm_phase(lds, g, S, E);
        if (G == 256 && bx >= 4) copy_g2_range(args, CP_S3, CP_S4, bx - 4, G - 4);
    }
#undef IN
#undef SEAM
#undef REPS
#undef REPSEAM
}

extern "C" void kernel_launch(void* const* d_in, const int* in_sizes, int n_in, void* d_out, int out_size, void* d_ws, size_t ws_size, hipStream_t stream) {
    static int grid = 0;
    if (grid == 0) {
        int dev = 0, cus = 0, per_cu = 0;
        (void)hipGetDevice(&dev);
        (void)hipDeviceGetAttribute(&cus, hipDeviceAttributeMultiprocessorCount, dev);
        if (hipFuncSetAttribute((const void*)fwd_kernel, hipFuncAttributeMaxDynamicSharedMemorySize, LDS_BYTES) != hipSuccess) { fprintf(stderr, "kernel_launch: hipFuncSetAttribute failed\n"); grid = -1; return; }
        if (hipOccupancyMaxActiveBlocksPerMultiprocessor(&per_cu, (const void*)fwd_kernel, 512, LDS_BYTES) != hipSuccess || per_cu < 1) { fprintf(stderr, "kernel_launch: occupancy query gave %d\n", per_cu); per_cu = 1; }
        (void)hipGetLastError();
        grid = cus * 1;
        if (ws_size < WS_END) { fprintf(stderr, "kernel_launch: workspace too small (%zu < %zu)\n", ws_size, (size_t)WS_END); grid = -1; return; }
    }
    if (grid < 0) return;
    if (hipMemsetAsync((char*)d_ws + WS_CTL, 0, CTL_ZERO_BYTES, stream) != hipSuccess) { fprintf(stderr, "kernel_launch: memset failed\n"); return; }
    Args a{};
    for (int i = 0; i < 19; ++i) a.in[i] = (const float*)d_in[i];
    a.out = (float*)d_out; a.ws = (unsigned char*)d_ws;
#if MK_SINGLE
    a.ph_lo = 0; a.ph_hi = N_PHASES;
    void* kargs[] = {&a};
    hipError_t e = hipLaunchCooperativeKernel((const void*)fwd_kernel, dim3(grid), dim3(512), kargs, LDS_BYTES, stream);
    if (e != hipSuccess) fprintf(stderr, "cooperative launch failed: %s (grid %d)\n", hipGetErrorString(e), grid);
#else
    for (int p = 0; p < N_PHASES; ++p) {
        a.ph_lo = p; a.ph_hi = p + 1;
        hipLaunchKernelGGL(fwd_kernel, dim3(grid), dim3(512), LDS_BYTES, stream, a);
    }
#endif
}
```
